# Optimizing an MI355X kernel written in HIP

```python
import math
import jax, jax.numpy as jnp
from jax import lax
import numpy as np

D_MODEL = 1024
BATCH = 8
SEQ = 2048
DEPTH = 2

N_MEM = 256
H_A = 4
D_A = 64
DV_A = 2 * D_A
Q_BLOCK = 128
ROPE_THETA = 500000.0
ROPE_DIM = D_A // 4
H_B = 4
DK_B = 64
DV_B = 128
GATE_RANK = 16
GATE_NORMALIZER = 16.0
H_C = 8
DK_C = 128
DV_C = 128
CONV_C = 4
CHUNK = 64
N_XA = 4
D_XA = D_MODEL // N_XA
D_FF = int(math.ceil(8 * D_MODEL / 3 / 128)) * 128
FFN_CONV = 3
LN_EPS = 1e-5
RMS_EPS = 1e-6
DEEPNORM_ALPHA = (2.0 * DEPTH) ** 0.25
DEEPNORM_BETA = (8.0 * DEPTH) ** -0.25
P0_SPLITS = (H_A * 2 * D_A, H_A * 2 * D_A, H_A * DV_A,
             H_B * DK_B, H_B * DK_B, H_B * DV_B, H_B * DV_B, GATE_RANK)
P1_SPLITS = (H_C * DK_C, H_C * DK_C, H_C * DV_C, H_C * DV_C, H_C, H_C)
P0 = sum(P0_SPLITS)
P1 = sum(P1_SPLITS)

kernel_name = 'hybrid_diffattn_gla_gdn_deepnorm'

F32 = jnp.float32


def _split(h, sizes):
    out, start = [], 0
    for s in sizes:
        out.append(h[..., start:start + s])
        start += s
    return out


def layer_norm(x, g, b):
    xf = x.astype(F32)
    xc = xf - jnp.mean(xf, axis=-1, keepdims=True)
    var = jnp.mean(xc * xc, axis=-1, keepdims=True)
    return (xc * lax.rsqrt(var + LN_EPS)).astype(x.dtype) * g + b


def rms_norm(x, g):
    xf = x.astype(F32)
    y = xf * lax.rsqrt(jnp.mean(xf * xf, axis=-1, keepdims=True) + RMS_EPS)
    return y * g.astype(F32)


def l2norm(x):
    return x * lax.rsqrt(jnp.sum(x * x, axis=-1, keepdims=True) + RMS_EPS)


def causal_dwconv(x, w, b=None):
    K = w.shape[0]
    S_ = x.shape[1]
    xp = jnp.pad(x, ((0, 0), (K - 1, 0), (0, 0)))
    y = xp[:, 0:S_] * w[0]
    for j in range(1, K):
        y = y + xp[:, j:j + S_] * w[j]
    if b is not None:
        y = y + b
    return y


def rope_cos_sin(pos):
    inv_freq = ROPE_THETA ** (-jnp.arange(0, ROPE_DIM, 2, dtype=F32) / ROPE_DIM)
    ang = pos.astype(F32)[..., None] * inv_freq
    return jnp.cos(ang), jnp.sin(ang)


def apply_partial_rope(x, cos, sin):
    half = ROPE_DIM // 2
    xf = x.astype(F32)
    x1 = xf[..., :half]
    x2 = xf[..., half:ROPE_DIM]
    rot = jnp.concatenate([x1 * cos - x2 * sin, x2 * cos + x1 * sin, xf[..., ROPE_DIM:]], axis=-1)
    return rot.astype(x.dtype)


def diff_attention(q, k, v, lam_vecs, norm_g, positions, layer_idx):
    B_, S_, _ = q.shape
    q = q.reshape(B_, S_, H_A, 2, D_A)
    k = k.reshape(B_, S_, H_A, 2, D_A)
    v = v.reshape(B_, S_, H_A, DV_A)
    cos, sin = rope_cos_sin(positions)
    cos = cos[:, :, None, None, :]
    sin = sin[:, :, None, None, :]
    q = apply_partial_rope(q, cos, sin) * (D_A ** -0.5)
    k = apply_partial_rope(k, cos, sin)
    lam_init = 0.8 - 0.6 * math.exp(-0.3 * layer_idx)
    lf = lam_vecs.astype(F32)
    lam = jnp.exp(jnp.sum(lf[0] * lf[1])) - jnp.exp(jnp.sum(lf[2] * lf[3])) + lam_init
    qh = q.transpose(0, 2, 3, 1, 4)
    kh = k.transpose(0, 2, 3, 1, 4)
    vh = v.transpose(0, 2, 1, 3)
    nb = S_ // Q_BLOCK
    qb = jnp.moveaxis(qh.reshape(B_, H_A, 2, nb, Q_BLOCK, D_A), 3, 0)
    kpos = jnp.arange(S_)

    def one_block(args):
        qi, bi = args
        s = jnp.einsum('bhmqd,bhmkd->bhmqk', qi, kh).astype(F32)
        qpos = bi * Q_BLOCK + jnp.arange(Q_BLOCK)
        s = jnp.where(kpos[None, :] <= qpos[:, None], s, -jnp.inf)
        p = jax.nn.softmax(s, axis=-1)
        a = p[:, :, 0] - lam * p[:, :, 1]
        return jnp.einsum('bhqk,bhkv->bhqv', a.astype(vh.dtype), vh)

    ob = lax.map(one_block, (qb, jnp.arange(nb)))
    o = jnp.moveaxis(ob, 0, 2).reshape(B_, H_A, S_, DV_A).transpose(0, 2, 1, 3)
    o = rms_norm(o, norm_g) * (1.0 - lam_init)
    return o.reshape(B_, S_, H_A * DV_A).astype(q.dtype)


def gla(q, k, v, g_low, r, w2, b2, norm_g):
    B_, S_, _ = q.shape
    N = S_ // CHUNK
    gk = jax.nn.log_sigmoid((g_low @ w2 + b2).astype(F32)) / GATE_NORMALIZER

    def heads(t, d):
        return t.astype(F32).reshape(B_, N, CHUNK, H_B, d).transpose(1, 0, 3, 2, 4)

    qc = heads(q, DK_B) * (DK_B ** -0.5)
    kc = heads(k, DK_B)
    vc = heads(v, DV_B)
    gc = heads(gk, DK_B)
    causal = jnp.tril(jnp.ones((CHUNK, CHUNK), dtype=bool))

    def step(state, inp):
        qi, ki, vi, gi = inp
        b = jnp.cumsum(gi, axis=2)
        inter = jnp.einsum('bhtk,bhkv->bhtv', qi * jnp.exp(b), state)
        diff = jnp.where(causal[:, :, None], b[:, :, :, None, :] - b[:, :, None, :, :], -jnp.inf)
        att = jnp.einsum('bhtk,bhsk,bhtsk->bhts', qi, ki, jnp.exp(diff))
        out = inter + jnp.einsum('bhts,bhsv->bhtv', att, vi)
        b_last = b[:, :, -1:, :]
        state = state * jnp.exp(b_last)[:, :, 0, :, None] + jnp.einsum('bhsk,bhsv->bhkv', ki * jnp.exp(b_last - b), vi)
        return state, out

    s0 = jnp.zeros((B_, H_B, DK_B, DV_B), F32)
    _, oc = lax.scan(step, s0, (qc, kc, vc, gc))
    o = oc.transpose(1, 0, 3, 2, 4).reshape(B_, S_, H_B, DV_B)
    o = rms_norm(o, norm_g) * jax.nn.silu(r.astype(F32)).reshape(B_, S_, H_B, DV_B)
    return o.reshape(B_, S_, H_B * DV_B).astype(q.dtype)


def gated_deltanet(q, k, v, beta_logit, a_logit, z, a_log, dt_bias, norm_g):
    B_, S_, _ = q.shape
    N = S_ // CHUNK

    def heads(t, d):
        return t.astype(F32).reshape(B_, N, CHUNK, H_C, d).transpose(0, 3, 1, 2, 4)

    def scal(t):
        return t.reshape(B_, N, CHUNK, H_C).transpose(0, 3, 1, 2)

    qh = l2norm(heads(q, DK_C)) * (DK_C ** -0.5)
    kh = l2norm(heads(k, DK_C))
    vh = heads(v, DV_C)
    beta = scal(jax.nn.sigmoid(beta_logit.astype(F32)))
    g = -jnp.exp(a_log.astype(F32)) * jax.nn.softplus(a_logit.astype(F32) + dt_bias.astype(F32))
    gc = jnp.cumsum(scal(g), axis=-1)
    incl = jnp.tril(jnp.ones((CHUNK, CHUNK), dtype=bool))
    strict = jnp.tril(jnp.ones((CHUNK, CHUNK), dtype=bool), k=-1)
    decay = jnp.exp(jnp.where(incl, gc[..., :, None] - gc[..., None, :], -jnp.inf))
    kb = kh * beta[..., None]
    m = jnp.where(strict, jnp.einsum('bhntk,bhnsk->bhnts', kb, kh) * decay, 0.0)
    eye = jnp.eye(CHUNK, dtype=F32)
    tinv = lax.linalg.triangular_solve(eye + m, jnp.broadcast_to(eye, m.shape), left_side=True, lower=True, unit_diagonal=True)
    u = jnp.einsum('bhnts,bhnsv->bhntv', tinv, vh * beta[..., None])
    w = jnp.einsum('bhnts,bhnsk->bhntk', tinv, kb * jnp.exp(gc)[..., None])
    qk = jnp.einsum('bhntk,bhnsk->bhnts', qh, kh) * decay
    qg = qh * jnp.exp(gc)[..., None]
    kg = kh * jnp.exp(gc[..., -1:] - gc)[..., None]
    g_last = jnp.exp(gc[..., -1])

    def step(state, inp):
        ui, wi, qgi, qki, kgi, gli = inp
        v_new = ui - jnp.einsum('bhck,bhkv->bhcv', wi, state)
        out = jnp.einsum('bhck,bhkv->bhcv', qgi, state) + jnp.einsum('bhts,bhsv->bhtv', qki, v_new)
        state = state * gli[:, :, None, None] + jnp.einsum('bhck,bhcv->bhkv', kgi, v_new)
        return state, out

    xs = (jnp.moveaxis(u, 2, 0), jnp.moveaxis(w, 2, 0), jnp.moveaxis(qg, 2, 0),
          jnp.moveaxis(qk, 2, 0), jnp.moveaxis(kg, 2, 0), jnp.moveaxis(g_last, 2, 0))
    s0 = jnp.zeros((B_, H_C, DK_C, DV_C), F32)
    _, oc = lax.scan(step, s0, xs)
    o = oc.transpose(1, 0, 3, 2, 4).reshape(B_, S_, H_C, DV_C)
    o = rms_norm(o, norm_g) * jax.nn.silu(z.astype(F32)).reshape(B_, S_, H_C, DV_C)
    return o.reshape(B_, S_, H_C * DV_C).astype(q.dtype)


def mixer_ab(x, positions, layer_idx, w_in, diff_lambda, diff_norm, gla_w2, gla_b2, gla_norm, w_out):
    h = x @ w_in
    aq, ak, av, bq, bk, bv, br, bg = _split(h, P0_SPLITS)
    oa = diff_attention(aq, ak, av, diff_lambda, diff_norm, positions, layer_idx)
    ob = gla(bq, bk, bv, bg, br, gla_w2, gla_b2, gla_norm)
    return jnp.concatenate([oa, ob], axis=-1) @ w_out


def mixer_c(x, w_in, conv_w, a_log, dt_bias, norm_g, w_out):
    h = x @ w_in
    q, k, v, z, bl, al = _split(h, P1_SPLITS)
    qkv = jax.nn.silu(causal_dwconv(jnp.concatenate([q, k, v], axis=-1), conv_w))
    q, k, v = _split(qkv, P1_SPLITS[:3])
    o = gated_deltanet(q, k, v, bl, al, z, a_log, dt_bias, norm_g)
    return o @ w_out


def memory_cross_attention(x, mem, wq, wkv, wo):
    B_, S_, _ = x.shape
    q = (x @ wq).reshape(B_, S_, N_XA, D_XA)
    k, v = _split(mem @ wkv, (D_MODEL, D_MODEL))
    k = k.reshape(B_, N_MEM, N_XA, D_XA)
    v = v.reshape(B_, N_MEM, N_XA, D_XA)
    s = jnp.einsum('bqhd,bkhd->bhqk', q, k).astype(F32) * (D_XA ** -0.5)
    p = jax.nn.softmax(s, axis=-1).astype(v.dtype)
    o = jnp.einsum('bhqk,bkhd->bqhd', p, v).reshape(B_, S_, D_MODEL)
    return o @ wo


def conv_ffn(x, w_in, conv_w, conv_b, w_out):
    h = causal_dwconv(x @ w_in, conv_w, conv_b)
    g, u = _split(h, (D_FF, D_FF))
    return (jax.nn.silu(g) * u) @ w_out


def setup_inputs(seed: int = 0) -> dict:
    key = jax.random.key(seed)
    keys = list(jax.random.split(key, 64))

    def nk():
        return keys.pop()

    def normal(shape, scale):
        return jax.random.normal(nk(), shape, F32) * scale

    def dense(fi, fo, scale=1.0):
        return normal((fi, fo), (fi ** -0.5) * scale)

    def gain(n):
        return 1.0 + normal((n,), 0.02)

    def bias(n):
        return normal((n,), 0.02)

    p = {}
    p['x'] = normal((BATCH, SEQ, D_MODEL), 1.0)
    p['mem'] = normal((BATCH, N_MEM, D_MODEL), 1.0)
    p['positions'] = jnp.broadcast_to(jnp.arange(SEQ, dtype=jnp.int32), (BATCH, SEQ))
    for l in range(DEPTH):
        if l % 2 == 0:
            p[f'w_in_{l}'] = dense(D_MODEL, P0)
            p[f'diff_lambda_{l}'] = normal((4, D_A), 0.1)
            p[f'diff_norm_{l}'] = gain(DV_A)
            p[f'gla_w2_{l}'] = dense(GATE_RANK, H_B * DK_B)
            p[f'gla_b2_{l}'] = bias(H_B * DK_B)
            p[f'gla_norm_{l}'] = gain(DV_B)
            p[f'w_mix_out_{l}'] = dense(H_A * DV_A + H_B * DV_B, D_MODEL, DEEPNORM_BETA)
        else:
            p[f'w_in_{l}'] = dense(D_MODEL, P1)
            p[f'gdn_conv_w_{l}'] = normal((CONV_C, 3 * H_C * DK_C), CONV_C ** -0.5)
            p[f'gdn_a_log_{l}'] = jnp.log(jax.random.uniform(nk(), (H_C,), F32, 1.0, 16.0))
            dt = jnp.exp(jax.random.uniform(nk(), (H_C,), F32, math.log(0.001), math.log(0.1)))
            p[f'gdn_dt_bias_{l}'] = dt + jnp.log(-jnp.expm1(-dt))
            p[f'gdn_norm_{l}'] = gain(DV_C)
            p[f'w_mix_out_{l}'] = dense(H_C * DV_C, D_MODEL, DEEPNORM_BETA)
        p[f'ln1_g_{l}'] = gain(D_MODEL)
        p[f'ln1_b_{l}'] = bias(D_MODEL)
        p[f'xa_wq_{l}'] = dense(D_MODEL, D_MODEL)
        p[f'xa_wkv_{l}'] = dense(D_MODEL, 2 * D_MODEL)
        p[f'xa_wo_{l}'] = dense(D_MODEL, D_MODEL, DEEPNORM_BETA)
        p[f'ln2_g_{l}'] = gain(D_MODEL)
        p[f'ln2_b_{l}'] = bias(D_MODEL)
        p[f'ffn_w_in_{l}'] = dense(D_MODEL, 2 * D_FF)
        p[f'ffn_conv_w_{l}'] = normal((FFN_CONV, 2 * D_FF), FFN_CONV ** -0.5)
        p[f'ffn_conv_b_{l}'] = bias(2 * D_FF)
        p[f'ffn_w_out_{l}'] = dense(D_FF, D_MODEL, DEEPNORM_BETA)
        p[f'ln3_g_{l}'] = gain(D_MODEL)
        p[f'ln3_b_{l}'] = bias(D_MODEL)
    return p


def reference(x, mem, positions,
              w_in_0, diff_lambda_0, diff_norm_0, gla_w2_0, gla_b2_0, gla_norm_0, w_mix_out_0,
              ln1_g_0, ln1_b_0, xa_wq_0, xa_wkv_0, xa_wo_0, ln2_g_0, ln2_b_0,
              ffn_w_in_0, ffn_conv_w_0, ffn_conv_b_0, ffn_w_out_0, ln3_g_0, ln3_b_0,
              w_in_1, gdn_conv_w_1, gdn_a_log_1, gdn_dt_bias_1, gdn_norm_1, w_mix_out_1,
              ln1_g_1, ln1_b_1, xa_wq_1, xa_wkv_1, xa_wo_1, ln2_g_1, ln2_b_1,
              ffn_w_in_1, ffn_conv_w_1, ffn_conv_b_1, ffn_w_out_1, ln3_g_1, ln3_b_1):
    mixer_params = [
        (w_in_0, diff_lambda_0, diff_norm_0, gla_w2_0, gla_b2_0, gla_norm_0, w_mix_out_0),
        (w_in_1, gdn_conv_w_1, gdn_a_log_1, gdn_dt_bias_1, gdn_norm_1, w_mix_out_1),
    ]
    common_params = [
        (ln1_g_0, ln1_b_0, xa_wq_0, xa_wkv_0, xa_wo_0, ln2_g_0, ln2_b_0,
         ffn_w_in_0, ffn_conv_w_0, ffn_conv_b_0, ffn_w_out_0, ln3_g_0, ln3_b_0),
        (ln1_g_1, ln1_b_1, xa_wq_1, xa_wkv_1, xa_wo_1, ln2_g_1, ln2_b_1,
         ffn_w_in_1, ffn_conv_w_1, ffn_conv_b_1, ffn_w_out_1, ln3_g_1, ln3_b_1),
    ]
    h = x
    for l in range(DEPTH):
        (ln1_g, ln1_b, xa_wq, xa_wkv, xa_wo, ln2_g, ln2_b,
         f_in, f_cw, f_cb, f_out, ln3_g, ln3_b) = common_params[l]
        if l % 2 == 0:
            mix = mixer_ab(h, positions, l, *mixer_params[l])
        else:
            mix = mixer_c(h, *mixer_params[l])
        h = layer_norm(DEEPNORM_ALPHA * h + mix, ln1_g, ln1_b)
        h = layer_norm(DEEPNORM_ALPHA * h + memory_cross_attention(h, mem, xa_wq, xa_wkv, xa_wo), ln2_g, ln2_b)
        h = layer_norm(DEEPNORM_ALPHA * h + conv_ffn(h, f_in, f_cw, f_cb, f_out), ln3_g, ln3_b)
    return h
```

```cpp
#include <hip/hip_runtime.h>
#include <hip/hip_cooperative_groups.h>
#include <cstdio>
#include <cstdint>
namespace cg = cooperative_groups;
__device__ __forceinline__ int tid_() { int t = threadIdx.x; asm volatile("" : "+v"(t)); return t; }
namespace pg8 {
#define PG8_LAS __attribute__((address_space(3)))
typedef unsigned short bf16_t;
typedef short bf16x8 __attribute__((ext_vector_type(8)));
typedef float f32x4 __attribute__((ext_vector_type(4)));
typedef unsigned u32x4 __attribute__((ext_vector_type(4)));
typedef unsigned u32x2 __attribute__((ext_vector_type(2)));
constexpr int BM = 256, BK = 64, HALF = 128, HTB = HALF * BK * 2  , STAGE_BYTES = 8 * HTB, NXCD = 8, WGM = 8;

__host__ __device__ __forceinline__ int lds_byte(int r, int c) { const int st = (r >> 4) * 2 + (c >> 5), rr = r & 15, cc = c & 31, ob = rr * 64 + cc * 2; return st * 1024 + (ob ^ (((ob >> 9) & 1) << 5)); }
__host__ __device__ __forceinline__ void stage_rc(int b, int& R, int& C) { const int st = b / 1024, sb = b % 1024, swz = sb ^ (((sb >> 9) & 1) << 5); R = (st >> 1) * 16 + swz / 64; C = (st & 1) * 32 + (swz % 64) / 2; }
__host__ __device__ __forceinline__ int perm32(int rho) { const int n = rho >> 4, i = rho & 15; return 8 * (i >> 2) + 4 * n + (i & 3); }

struct Unit { int pm, pn; };
struct Gemm { const bf16_t* A; const bf16_t* Bt; int M, N, K, lda; };

struct StaticOrder {
    int nM, nN, nwg, G, c;
    __host__ __device__ void init(int M, int N, int G_, int c_) { nM = M / BM; nN = N / BM; nwg = nM * nN; G = G_; c = c_; }
    __host__ __device__ bool next(int i, Unit& u) const {
        const long L = (long)i * G + c; if (L >= nwg) return false;
        int wgid = (int)L; { const int q = nwg / NXCD, r = nwg % NXCD, xcd = wgid % NXCD, off = wgid / NXCD; wgid = (xcd < r ? xcd * (q + 1) : r * (q + 1) + (xcd - r) * q) + off; }
        const int nig = WGM * nN, gid = wgid / nig, fm = gid * WGM, gsz = (nM - fm) < WGM ? (nM - fm) : WGM;
        u.pm = fm + ((wgid % nig) % gsz); u.pn = (wgid % nig) / gsz; return true;
    }
    __device__ __forceinline__ void a_ready(const Unit&) const {}
    __device__ __forceinline__ void done(const Unit&) const {}
};
__device__ __forceinline__ unsigned cvt_pk_bf16(float lo, float hi) { typedef float f2 __attribute__((ext_vector_type(2))); typedef __bf16 b2 __attribute__((ext_vector_type(2))); f2 v = {lo, hi}; b2 b = __builtin_convertvector(v, b2); return __builtin_bit_cast(unsigned, b); }
struct EpiBf16 {
    static constexpr bool PERM = true, AFTER_DRAIN = false;
    bf16_t* O; int ldc; int gate_pn; float* G16; bf16_t* halo;
    __device__ __forceinline__ void operator()(const f32x4 (&acc)[2][2][4][2], const Unit& u, int wr, int wc, int fr, int fq) const {
        const int row0 = u.pm * BM + wr * 64 + fr;
        if (u.pn >= gate_pn) {
            if (wc == 0 && fq < 2) {
#pragma unroll
                for (int ai = 0; ai < 2; ++ai)
#pragma unroll
                    for (int m = 0; m < 4; ++m) { float* p = G16 + (size_t)(row0 + ai * HALF + m * 16) * 16 + 8 * fq;
                        *(f32x4*)p = acc[ai][0][m][0]; *(f32x4*)(p + 4) = acc[ai][0][m][1]; }
            }
            return;
        }
        const int col0 = u.pn * BM + wc * 32 + 8 * fq;
#pragma unroll
        for (int ai = 0; ai < 2; ++ai)
#pragma unroll
            for (int m = 0; m < 4; ++m) { const int row = row0 + ai * HALF + m * 16; bf16_t* rowp = O + (size_t)row * ldc + col0;
#pragma unroll
                for (int bj = 0; bj < 2; ++bj) { const f32x4 v0 = acc[ai][bj][m][0], v1 = acc[ai][bj][m][1];
                    u32x4 w; w.x = cvt_pk_bf16(v0[0], v0[1]); w.y = cvt_pk_bf16(v0[2], v0[3]); w.z = cvt_pk_bf16(v1[0], v1[1]); w.w = cvt_pk_bf16(v1[2], v1[3]);
                    *(u32x4*)(rowp + bj * HALF) = w;
                    if (halo != nullptr && m == 3 && fr >= 13 && (col0 + bj * HALF) < 3072) *(u32x4*)(halo + ((size_t)(row >> 6) * 3 + (fr - 13)) * 3072 + col0 + bj * HALF) = w; } }
    }
};

__device__ __forceinline__ float dpp_ror1(float v) { return __builtin_bit_cast(float, __builtin_amdgcn_update_dpp(0, __builtin_bit_cast(int, v), 0x121, 0xf, 0xf, false)); }
__device__ __forceinline__ float dpp_ror2(float v) { return __builtin_bit_cast(float, __builtin_amdgcn_update_dpp(0, __builtin_bit_cast(int, v), 0x122, 0xf, 0xf, false)); }
struct EpiFfn {
    static constexpr bool PERM = true, AFTER_DRAIN = false;
    bf16_t* Act; const float* cw; const float* cbias; float* RAW; PG8_LAS unsigned char* xch;
    __device__ __forceinline__ void operator()(const f32x4 (&acc)[2][2][4][2], const Unit& u, int wr, int wc, int fr, int fq) const {
        const int c8 = wc * 32 + 8 * fq;
        const int ch = u.pn * 128 + c8;
        if (fr >= 14) {
#pragma unroll
            for (int ai = 0; ai < 2; ++ai)
#pragma unroll
                for (int bj = 0; bj < 2; ++bj)
#pragma unroll
                    for (int n = 0; n < 2; ++n) *(PG8_LAS f32x4*)(xch + ((((ai * 2 + wr) * 2 + (fr - 14)) * 256) + bj * 128 + c8 + 4 * n) * 4) = acc[ai][bj][3][n];
        }
        asm volatile("s_waitcnt lgkmcnt(0)" ::: "memory"); __builtin_amdgcn_s_barrier(); asm volatile("" ::: "memory");
        if (wr == 0 && fr < 2) {
#pragma unroll
            for (int n = 0; n < 2; ++n) { float* p = RAW + ((size_t)u.pm * 4 + fr) * 5632 + ch + 4 * n; *(f32x4*)p = acc[0][0][0][n]; *(f32x4*)(p + 2816) = acc[0][1][0][n]; } }
        if (wr == 1 && fr >= 14) {
#pragma unroll
            for (int n = 0; n < 2; ++n) { float* p = RAW + ((size_t)u.pm * 4 + 2 + (fr - 14)) * 5632 + ch + 4 * n; *(f32x4*)p = acc[1][0][3][n]; *(f32x4*)(p + 2816) = acc[1][1][3][n]; } }
#pragma unroll
        for (int n = 0; n < 2; ++n) {
            asm volatile("" ::: "memory");
            f32x4 wv[2][4];
#pragma unroll
            for (int bj = 0; bj < 2; ++bj) {
#pragma unroll
                for (int j = 0; j < 3; ++j) wv[bj][j] = *(const f32x4*)(cw + (size_t)j * 5632 + bj * 2816 + ch + 4 * n);
                wv[bj][3] = *(const f32x4*)(cbias + bj * 2816 + ch + 4 * n); }
#pragma unroll
            for (int ai = 0; ai < 2; ++ai) {
                const int prev = (wr == 1) ? (ai * 2 + 0) : (ai == 1 ? 1 : -1);
                f32x4 vm1[2];
#pragma unroll
                for (int bj = 0; bj < 2; ++bj) { f32x4 z = {0.f, 0.f, 0.f, 0.f};
                    if (prev >= 0 && fr >= 14) z = *(PG8_LAS const f32x4*)(xch + (((prev * 2 + (fr - 14)) * 256) + bj * 128 + c8 + 4 * n) * 4);
                    vm1[bj] = z; }
#pragma unroll
                for (int m = 0; m < 4; ++m) {
                    f32x4 cv[2];
#pragma unroll
                    for (int bj = 0; bj < 2; ++bj) { const f32x4 x = acc[ai][bj][m][n]; const f32x4 xm = (m == 0) ? vm1[bj] : acc[ai][bj][m == 0 ? 0 : m - 1][n];
                        f32x4 r;
#pragma unroll
                        for (int e = 0; e < 4; ++e) { const float a1 = dpp_ror1(x[e]), b1 = dpp_ror1(xm[e]), a2 = dpp_ror2(x[e]), b2 = dpp_ror2(xm[e]);
                            const float p1 = (fr == 0) ? b1 : a1, p2 = (fr < 2) ? b2 : a2;
                            r[e] = wv[bj][3][e] + wv[bj][2][e] * x[e] + wv[bj][1][e] * p1 + wv[bj][0][e] * p2; }
                        cv[bj] = r; }
                    float o[4];
#pragma unroll
                    for (int e = 0; e < 4; ++e) { const float g = cv[0][e]; o[e] = g * __builtin_amdgcn_rcpf(1.f + __expf(-g)) * cv[1][e]; }
                    u32x2 w; w.x = cvt_pk_bf16(o[0], o[1]); w.y = cvt_pk_bf16(o[2], o[3]);
                    const int row = u.pm * BM + ai * HALF + wr * 64 + m * 16 + fr;
                    *(u32x2*)(Act + (size_t)row * 2816 + ch + 4 * n) = w;
                }
            }
        }
    }
};
template <bool LN> struct EpiRes {
    static constexpr bool PERM = false, AFTER_DRAIN = false;
    const float* resid; float* out; const float* stats; const float* g; const float* bta; float alpha; int pad_;
    __device__ __forceinline__ void operator()(const f32x4 (&acc)[2][2][4][2], const Unit& u, int wr, int wc, int fr, int fq) const {
        typedef float f32x2v __attribute__((ext_vector_type(2)));
        const int row0 = u.pm * BM + wr * 64 + fr, col0 = u.pn * BM + wc * 32 + 4 * fq;
#pragma unroll
        for (int bj = 0; bj < 2; ++bj)
#pragma unroll
            for (int n = 0; n < 2; ++n) {
                f32x4 gv, bv;
                if constexpr (LN) { gv = *(const f32x4*)(g + col0 + bj * HALF + n * 16) * alpha; bv = *(const f32x4*)(bta + col0 + bj * HALF + n * 16) * alpha; }
                else { gv = (f32x4){alpha, alpha, alpha, alpha}; bv = (f32x4){0.f, 0.f, 0.f, 0.f}; }
#pragma unroll
                for (int ai = 0; ai < 2; ++ai)
#pragma unroll
                    for (int m = 0; m < 4; ++m) { const int row = row0 + ai * HALF + m * 16; const size_t o = (size_t)row * 1024 + col0 + bj * HALF + n * 16;
                        f32x4 r = *(const f32x4*)(resid + o);
                        if constexpr (LN) { const f32x2v sr = *(const f32x2v*)(stats + 2 * row); r = (r - sr.x) * sr.y; }
                        *(f32x4*)(out + o) = r * gv + bv + acc[ai][bj][m][n]; } }
    }
};
template <class Epi, class Sched, bool ALIGN_EPI = false, bool SP2 = false>
__device__ __forceinline__ void gemm_phase(PG8_LAS unsigned char* lds, const Gemm g, const Sched& S, const Epi& E) {
    const int tid = tid_(), wid = __builtin_amdgcn_readfirstlane(tid >> 6), lane = tid & 63, wr = wid >> 2, wc = wid & 3, fr = lane & 15, fq = lane >> 4;
    const int K = g.K, nt = K / BK;
    unsigned voffA[2], voffB[2];
#pragma unroll
    for (int i = 0; i < 2; ++i) { int R, C; stage_rc(tid * 16 + i * 8192, R, C); const int Rb = Epi::PERM ? ((R & ~31) + perm32(R & 31)) : R;
        voffA[i] = (unsigned)(R * g.lda + C) * 2u; voffB[i] = (unsigned)(Rb * K + C) * 2u; }
    const size_t kstep = (size_t)(BK * 2);
    const size_t hstepA = (size_t)HALF * g.lda * 2, hstepB = (size_t)HALF * K * 2;
    const size_t tstepA = 2 * hstepA, tstepB = 2 * hstepB;
    const unsigned ldsw = (unsigned)wid * 1024u;
    const int aoff = lds_byte(wr * 64 + fr, fq * 8), boff = lds_byte(wc * 32 + fr, fq * 8);
#define PG8_SA(b, h) (((b) * 2 + (h)) * HTB)
#define PG8_SB(b, h) ((4 + (b) * 2 + (h)) * HTB)
#define PG8_STAGE(bufoff, gbase, voff) do { _Pragma("unroll") for (int _i = 0; _i < 2; ++_i) \
        __builtin_amdgcn_global_load_lds((const unsigned*)((const char*)(gbase) + (voff)[_i]), (PG8_LAS unsigned*)(lds + (bufoff) + ldsw + _i * 8192), 16, 0, 0); } while (0)
#define PG8_LDA(dst, b, h) do { _Pragma("unroll") for (int m = 0; m < 4; ++m) _Pragma("unroll") for (int k = 0; k < 2; ++k) dst[m][k] = *(const PG8_LAS bf16x8*)(lds + PG8_SA(b, h) + aoff + m * 2048 + k * 1024); } while (0)
#define PG8_LDB(dst, b, h) do { _Pragma("unroll") for (int n = 0; n < 2; ++n) _Pragma("unroll") for (int k = 0; k < 2; ++k) dst[n][k] = *(const PG8_LAS bf16x8*)(lds + PG8_SB(b, h) + boff + n * 2048 + k * 1024); } while (0)
#define PG8_MMA(ai, bj, At, Bt) do { __builtin_amdgcn_s_setprio(1); _Pragma("unroll") for (int m = 0; m < 4; ++m) _Pragma("unroll") for (int n = 0; n < 2; ++n) _Pragma("unroll") for (int k = 0; k < 2; ++k) \
        acc[ai][bj][m][n] = __builtin_amdgcn_mfma_f32_16x16x32_bf16(Bt[n][k], At[m][k], acc[ai][bj][m][n], 0, 0, 0); __builtin_amdgcn_s_setprio(0); } while (0)
#define PG8_WAIT_V(n) asm volatile("s_waitcnt vmcnt(" #n ")" ::: "memory")
#define PG8_WAIT_L(n) asm volatile("s_waitcnt lgkmcnt(" #n ")" ::: "memory")
#define PG8_BAR __builtin_amdgcn_s_barrier()
#define PG8_SCHED __builtin_amdgcn_sched_barrier(0)
    Unit cur, nxt; int ui = 0;
    if (!S.next(0, cur)) return;
    f32x4 acc[2][2][4][2];
#pragma unroll
    for (int a = 0; a < 2; ++a)
#pragma unroll
        for (int b = 0; b < 2; ++b)
#pragma unroll
            for (int m = 0; m < 4; ++m)
#pragma unroll
                for (int n = 0; n < 2; ++n) acc[a][b][m][n] = (f32x4){0.f, 0.f, 0.f, 0.f};
    bf16x8 At[4][2], B0[2][2], B1[2][2];
    const char* cA = (const char*)g.A + (size_t)cur.pm * tstepA; const char* cB = (const char*)g.Bt + (size_t)cur.pn * tstepB;
    S.a_ready(cur);
    if constexpr (SP2) {
        PG8_STAGE(PG8_SB(0, 0), cB, voffB); PG8_STAGE(PG8_SB(0, 1), cB + hstepB, voffB); PG8_STAGE(PG8_SA(0, 0), cA, voffA); PG8_STAGE(PG8_SA(0, 1), cA + hstepA, voffA);
        if (wr == 1) PG8_BAR;
        PG8_WAIT_V(2); PG8_BAR;
        PG8_STAGE(PG8_SB(1, 0), cB + kstep, voffB); PG8_STAGE(PG8_SA(1, 0), cA + kstep, voffA); PG8_STAGE(PG8_SB(1, 1), cB + hstepB + kstep, voffB);
        PG8_WAIT_V(6); PG8_BAR;
    } else {
        PG8_STAGE(PG8_SB(0, 0), cB, voffB); PG8_STAGE(PG8_SA(0, 0), cA, voffA); PG8_STAGE(PG8_SB(0, 1), cB + hstepB, voffB); PG8_STAGE(PG8_SA(0, 1), cA + hstepA, voffA);
        if (wr == 1) PG8_BAR;
        PG8_WAIT_V(4); PG8_BAR;
        PG8_STAGE(PG8_SB(1, 0), cB + kstep, voffB); PG8_STAGE(PG8_SA(1, 0), cA + kstep, voffA); PG8_STAGE(PG8_SB(1, 1), cB + hstepB + kstep, voffB);
        PG8_WAIT_V(6); PG8_BAR;
    }
    for (;;) {
        const bool has_next = S.next(ui + 1, nxt);
        const char* nA = has_next ? (const char*)g.A + (size_t)nxt.pm * tstepA : cA; const char* nB = has_next ? (const char*)g.Bt + (size_t)nxt.pn * tstepB : cB;
        for (int t = 0; t < nt; t += 2) {
            const bool last = (t == nt - 2);
            const char* a1 = cA + (size_t)(t + 1) * kstep;
            const char* a2 = last ? nA : cA + (size_t)(t + 2) * kstep; const char* b2 = last ? nB : cB + (size_t)(t + 2) * kstep;
            const char* a3 = a2 + kstep; const char* b3 = b2 + kstep;
            if (last && has_next) S.a_ready(nxt);
            if constexpr (SP2) {
            PG8_LDB(B0, 0, 0); PG8_LDB(B1, 0, 1); PG8_SCHED; PG8_LDA(At, 0, 0); PG8_STAGE(PG8_SA(1, 1), a1 + hstepA, voffA);
            PG8_WAIT_V(8); PG8_WAIT_L(0); PG8_BAR; PG8_MMA(0, 0, At, B0); PG8_MMA(0, 1, At, B1); PG8_BAR; PG8_SCHED;
            PG8_LDA(At, 0, 1); PG8_STAGE(PG8_SB(0, 0), b2, voffB); PG8_STAGE(PG8_SB(0, 1), b2 + hstepB, voffB); PG8_STAGE(PG8_SA(0, 0), a2, voffA);
            PG8_WAIT_V(8); PG8_WAIT_L(0); PG8_BAR; PG8_MMA(1, 0, At, B0); PG8_MMA(1, 1, At, B1); PG8_BAR; PG8_SCHED;
            PG8_LDB(B0, 1, 0); PG8_LDB(B1, 1, 1); PG8_SCHED; PG8_LDA(At, 1, 0); PG8_STAGE(PG8_SA(0, 1), a2 + hstepA, voffA);
            PG8_WAIT_V(8); PG8_WAIT_L(0); PG8_BAR; PG8_MMA(0, 0, At, B0); PG8_MMA(0, 1, At, B1); PG8_BAR; PG8_SCHED;
            PG8_LDA(At, 1, 1); PG8_STAGE(PG8_SB(1, 0), b3, voffB); PG8_STAGE(PG8_SB(1, 1), b3 + hstepB, voffB); PG8_STAGE(PG8_SA(1, 0), a3, voffA);
            PG8_WAIT_V(8); PG8_WAIT_L(0); PG8_BAR; PG8_MMA(1, 0, At, B0); PG8_MMA(1, 1, At, B1); PG8_BAR; PG8_SCHED;
            } else {
            PG8_LDB(B0, 0, 0); PG8_SCHED; PG8_LDA(At, 0, 0); PG8_STAGE(PG8_SA(1, 1), a1 + hstepA, voffA);
            PG8_WAIT_L(8); PG8_BAR; PG8_WAIT_L(0); PG8_MMA(0, 0, At, B0); PG8_BAR; PG8_SCHED;
            PG8_LDB(B1, 0, 1); PG8_STAGE(PG8_SB(0, 0), b2, voffB);
            PG8_BAR; PG8_WAIT_L(0); PG8_MMA(0, 1, At, B1); PG8_BAR;
            PG8_LDA(At, 0, 1); PG8_STAGE(PG8_SA(0, 0), a2, voffA);
            PG8_BAR; PG8_WAIT_L(0); PG8_MMA(1, 0, At, B0); PG8_BAR; PG8_SCHED;
            PG8_STAGE(PG8_SB(0, 1), b2 + hstepB, voffB);
            PG8_WAIT_V(6); PG8_BAR; PG8_MMA(1, 1, At, B1); PG8_BAR;
            PG8_LDB(B0, 1, 0); PG8_SCHED; PG8_LDA(At, 1, 0); PG8_STAGE(PG8_SA(0, 1), a2 + hstepA, voffA);
            PG8_WAIT_L(8); PG8_BAR; PG8_WAIT_L(0); PG8_MMA(0, 0, At, B0); PG8_BAR; PG8_SCHED;
            PG8_LDB(B1, 1, 1); PG8_STAGE(PG8_SB(1, 0), b3, voffB);
            PG8_BAR; PG8_WAIT_L(0); PG8_MMA(0, 1, At, B1); PG8_BAR;
            PG8_LDA(At, 1, 1); PG8_STAGE(PG8_SA(1, 0), a3, voffA);
            PG8_BAR; PG8_WAIT_L(0); PG8_MMA(1, 0, At, B0); PG8_BAR; PG8_SCHED;
            PG8_STAGE(PG8_SB(1, 1), b3 + hstepB, voffB);
            PG8_WAIT_V(6); PG8_BAR; PG8_MMA(1, 1, At, B1); PG8_BAR;
            }
        }
        if constexpr (ALIGN_EPI) { if (wr == 0) PG8_BAR; }
        if constexpr (!Epi::AFTER_DRAIN) { E(acc, cur, wr, wc, fr, fq); S.done(cur); }
        if (!has_next) break;
#pragma unroll
        for (int a = 0; a < 2; ++a)
#pragma unroll
            for (int b = 0; b < 2; ++b)
#pragma unroll
                for (int m = 0; m < 4; ++m)
#pragma unroll
                    for (int n = 0; n < 2; ++n) acc[a][b][m][n] = (f32x4){0.f, 0.f, 0.f, 0.f};
        cur = nxt; cA = nA; cB = nB; ++ui;
        if constexpr (ALIGN_EPI) { if (wr == 1) PG8_BAR; }
    }
    PG8_WAIT_V(0);
    if constexpr (!ALIGN_EPI) { if (wr == 0) PG8_BAR; }
    PG8_BAR;
    if constexpr (Epi::AFTER_DRAIN) { E.fused(acc, cur, wr, wc, fr, fq, lds, wid, lane); S.done(cur); }
#undef PG8_SA
#undef PG8_SB
#undef PG8_STAGE
#undef PG8_LDA
#undef PG8_LDB
#undef PG8_MMA
#undef PG8_WAIT_V
#undef PG8_WAIT_L
#undef PG8_BAR
#undef PG8_SCHED
}
}
#define LAS __attribute__((address_space(3)))
#define DI __device__ __forceinline__
typedef unsigned short bf16;
typedef short bf16x8 __attribute__((ext_vector_type(8)));
typedef short s16x4 __attribute__((ext_vector_type(4)));
typedef float f32x4 __attribute__((ext_vector_type(4)));
typedef float f32x16 __attribute__((ext_vector_type(16)));
typedef unsigned u32x4 __attribute__((ext_vector_type(4)));
typedef unsigned u32x2 __attribute__((ext_vector_type(2)));
#define LDS_WAIT() asm volatile("s_waitcnt lgkmcnt(0)" ::: "memory")
#define MFMA32(a, b, c) __builtin_amdgcn_mfma_f32_32x32x16_bf16((a), (b), (c), 0, 0, 0)
#define LBAR() do { asm volatile("s_waitcnt lgkmcnt(0)" ::: "memory"); __builtin_amdgcn_s_barrier(); asm volatile("" ::: "memory"); } while (0)

constexpr int T = 16384, D = 1024, SEQ = 2048, NB = 8, TM = 2048;
constexpr int DFF = 2816, DFH = 1408;
constexpr float ALPHA = 1.4142135623730951f;
constexpr float LOG2E = 1.4426950408889634f;
constexpr size_t MiB = 1u << 20;
constexpr size_t WS_ROPE = 0;
constexpr size_t WS_G16 = 1 * MiB;
constexpr size_t WS_HALO = 2 * MiB;
constexpr size_t WS_MEMB = 7 * MiB;
constexpr size_t WS_KVM = 11 * MiB;
constexpr size_t WS_WIN = 19 * MiB;
constexpr size_t WS_WOUT = 28 * MiB, WS_WQ = 30 * MiB, WS_WKV = 32 * MiB, WS_WO = 36 * MiB, WS_WFI = 38 * MiB, WS_WFOA = 49 * MiB, WS_WFOB = 52 * MiB;
constexpr size_t WS_HB = 56 * MiB;
constexpr size_t WS_BIG = 88 * MiB;
constexpr size_t WS_ACT = 176 * MiB;
constexpr size_t WS_WKV1 = 240 * MiB;
constexpr int LDS_BYTES = 147456;

DI unsigned cvtpk(float lo, float hi) { return pg8::cvt_pk_bf16(lo, hi); }
DI bf16 f2bf(float f) { return (bf16)(cvtpk(f, 0.f) & 0xffffu); }
DI float bf2f(bf16 v) { return __uint_as_float(((unsigned)v) << 16); }
DI float bflo(unsigned w) { return __uint_as_float(w << 16); }
DI float bfhi(unsigned w) { return __uint_as_float(w & 0xffff0000u); }
DI int crow(int i, int h) { return (i & 3) + 8 * (i >> 2) + 4 * h; }
DI float wave_sum(float v) {
#pragma unroll
    for (int o = 1; o < 64; o <<= 1) v += __shfl_xor(v, o);
    return v;
}
DI float siluf(float x) { return x * __builtin_amdgcn_rcpf(1.f + __expf(-x)); }
DI float sigmoidf_(float x) { return __builtin_amdgcn_rcpf(1.f + __expf(-x)); }
DI bf16x8 pack8(const f32x16& x, int s) { u32x4 p; p.x = cvtpk(x[8 * s], x[8 * s + 1]); p.y = cvtpk(x[8 * s + 2], x[8 * s + 3]); p.z = cvtpk(x[8 * s + 4], x[8 * s + 5]); p.w = cvtpk(x[8 * s + 6], x[8 * s + 7]); return __builtin_bit_cast(bf16x8, p); }
DI bf16x8 lds_rd16(LAS const unsigned char* p) { return *(LAS const bf16x8*)p; }
DI bf16x8 lds_rd8x2(LAS const unsigned char* p) { const s16x4 lo = *(LAS const s16x4*)p, hi = *(LAS const s16x4*)(p + 16); return __builtin_shufflevector(lo, hi, 0, 1, 2, 3, 4, 5, 6, 7); }
DI void unpack8(const u32x4 w, float* f) { f[0] = bflo(w.x); f[1] = bfhi(w.x); f[2] = bflo(w.y); f[3] = bfhi(w.y); f[4] = bflo(w.z); f[5] = bfhi(w.z); f[6] = bflo(w.w); f[7] = bfhi(w.w); }
DI u32x4 packf8(const float* f) { u32x4 w; w.x = cvtpk(f[0], f[1]); w.y = cvtpk(f[2], f[3]); w.z = cvtpk(f[4], f[5]); w.w = cvtpk(f[6], f[7]); return w; }
DI void st16_wt(void* p, u32x4 v) { asm volatile("global_store_dwordx4 %0, %1, off sc1\n\ts_nop 1" :: "v"(p), "v"(v) : "memory"); }
DI void zero16(f32x16& a) {
#pragma unroll
    for (int i = 0; i < 16; ++i) a[i] = 0.f;
}

#define XB_TMO      128
#define XB_XCNT(j)  (256  + 64 * (j))
#define XB_XSUB(j)  (1280 + 64 * (j))
#define XB_XGEN(j)  (2304 + 64 * (j))
#define XB_TOP      3328
#define XB_TOPGEN   3392
#define XCD_BAR_WORDS 3456
#define XB_SPIN_CAP (1u << 18)

__device__ __forceinline__ unsigned xb_ld(unsigned* p)              { return __hip_atomic_load(p, __ATOMIC_RELAXED, __HIP_MEMORY_SCOPE_AGENT); }
__device__ __forceinline__ unsigned xb_add(unsigned* p, unsigned v) { return __hip_atomic_fetch_add(p, v, __ATOMIC_RELAXED, __HIP_MEMORY_SCOPE_AGENT); }
__device__ __forceinline__ unsigned xb_xcc_id() { return (unsigned)__builtin_amdgcn_s_getreg((3 << 11) | 20) & 0xFu; }
#define XB_SPIN(cond, bar) do { unsigned _sp = 0; while (cond) { __builtin_amdgcn_s_sleep(1); \
    if ((++_sp & 255u) == 0u) { if (xb_ld(&(bar)[XB_TMO])) break; if (_sp > XB_SPIN_CAP) { atomicAdd(&(bar)[XB_TMO], 1u); break; } } } } while (0)

struct XcdBarrier {
    unsigned* bar; unsigned x;
    volatile LAS unsigned* st;
};

__device__ __forceinline__ XcdBarrier xcd_barrier_post(unsigned* bar, volatile LAS unsigned* st) {
    XcdBarrier b; b.bar = bar; b.x = xb_xcc_id(); b.st = st;
    if (threadIdx.x == 0) (void)xb_add(&bar[XB_XCNT(b.x)], 1u);
    return b;
}
__device__ __forceinline__ void xcd_barrier_complete(unsigned* bar, unsigned x, unsigned& nloc, unsigned& nx) {
    const unsigned G = gridDim.x * gridDim.y * gridDim.z;
    unsigned sum, cnt, mine, sp = 0u;
    for (;;) {
        sum = 0u; cnt = 0u; mine = 0u;
#pragma unroll
        for (unsigned j = 0; j < 16; ++j) { const unsigned c = xb_ld(&bar[XB_XCNT(j)]); sum += c; cnt += (c > 0u) ? 1u : 0u; mine = (j == x) ? c : mine; }
        if (sum == G) break;
        __builtin_amdgcn_s_sleep(1);
        if ((++sp & 255u) == 0u) { if (xb_ld(&bar[XB_TMO])) break; if (sp > XB_SPIN_CAP) { atomicAdd(&bar[XB_TMO], 1u); break; } }
    }
    nloc = mine > 0u ? mine : 1u; nx = cnt > 0u ? cnt : 1u;
}

__device__ __forceinline__ void xcd_barrier(const XcdBarrier& b) {
    asm volatile("s_waitcnt vmcnt(0)" ::: "memory");
    __syncthreads();
    if (threadIdx.x == 0) {
        unsigned* bar = b.bar;
        __builtin_amdgcn_s_waitcnt(0);
        unsigned nloc = b.st[0], nx = b.st[1];
        if (nloc == 0u) { xcd_barrier_complete(bar, b.x, nloc, nx); b.st[0] = nloc; b.st[1] = nx; }
        const unsigned old = xb_add(&bar[XB_XSUB(b.x)], 1u);
        const unsigned gen = old / nloc;
        if (old + 1u == (gen + 1u) * nloc) {
            __builtin_amdgcn_fence(__ATOMIC_RELEASE, "agent");
            asm volatile("s_waitcnt vmcnt(0)" ::: "memory");
            const unsigned og = xb_add(&bar[XB_TOP], 1u);
            const unsigned tg = og / nx;
            if (og + 1u == (tg + 1u) * nx) xb_add(&bar[XB_TOPGEN], 1u);
            else XB_SPIN(xb_ld(&bar[XB_TOPGEN]) == tg, bar);
            __builtin_amdgcn_fence(__ATOMIC_ACQUIRE, "agent");
            xb_add(&bar[XB_XGEN(b.x)], 1u);
            asm volatile("s_waitcnt vmcnt(0)" ::: "memory");
        } else {
            XB_SPIN(xb_ld(&bar[XB_XGEN(b.x)]) == gen, bar);
            __builtin_amdgcn_fence(__ATOMIC_ACQUIRE, "agent");
            asm volatile("s_waitcnt vmcnt(0)" ::: "memory");
        }
    }
    __syncthreads();
}
constexpr size_t WS_BAR = 55 * MiB;
struct Args { const float* in[42]; float* out; unsigned char* ws; int ph_lo, ph_hi; };
#if defined(__HIP_DEVICE_COMPILE__)
DI const float* inptr(int i) { const void* p = (const void*)__builtin_amdgcn_kernarg_segment_ptr(); asm volatile("" : "+s"(p)); return ((const float* const*)p)[i]; }
#else
DI const float* inptr(int) { return nullptr; }
#endif

DI void transpose_item(const float* W, int ldw, bf16* WT, int ldt, int k0, int n0, int drow0, int dk0, LAS float* scr, int lane) {
    float tv[32];
#pragma unroll
    for (int i = 0; i < 32; ++i) { const int kk = 2 * i + (lane >> 5); tv[i] = W[(size_t)(k0 + kk) * ldw + n0 + (lane & 31)]; }
#pragma unroll
    for (int i = 0; i < 32; ++i) { const int kk = 2 * i + (lane >> 5); scr[kk * 33 + (lane & 31)] = tv[i]; }
    LDS_WAIT();
    const int c = lane & 7;
#pragma unroll
    for (int j = 0; j < 4; ++j) { const int n = (lane >> 3) + 8 * j; const LAS float* s = scr + (8 * c) * 33 + n;
        u32x4 o; o.x = cvtpk(s[0 * 33], s[1 * 33]); o.y = cvtpk(s[2 * 33], s[3 * 33]); o.z = cvtpk(s[4 * 33], s[5 * 33]); o.w = cvtpk(s[6 * 33], s[7 * 33]);
        *(u32x4*)(WT + (size_t)(drow0 + n) * ldt + dk0 + 8 * c) = o; }
    LDS_WAIT();
}
DI void convert_weights(const Args& a, int layer, LAS unsigned char* lds, int gw, int NGW, int wave, int lane) {
    unsigned char* ws = a.ws;
    const int cb = layer ? 29 : 10;
    const float* w_in = inptr(layer ? 23 : 3); const int nin = layer ? 4112 : 3088, nmain = layer ? 4096 : 3072;
    const float* w_out = inptr(layer ? 28 : 9);
    const float *wq = inptr(cb + 2), *wkv = inptr(cb + 3), *wo = inptr(cb + 4), *fin = inptr(cb + 7), *fout = inptr(cb + 10);
    LAS float* scr = (LAS float*)(lds + wave * 16384);
    const int I_IN = 16 * (nmain / 32), I_SQ = 16 * 32, I_KV = 16 * 64, I_FI = 16 * 176, I_FO = 44 * 32;
    const int NITEMS = I_IN + 3 * I_SQ + I_KV + I_FI + I_FO;
    for (int it = gw; it < NITEMS; it += NGW) {
        int r = it;
        if (r < I_IN) { const int nb = nmain / 32, kb = r / nb, n0 = 32 * (r % nb); transpose_item(w_in, nin, (bf16*)(ws + WS_WIN), 1024, 64 * kb, n0, n0, 64 * kb, scr, lane); continue; } r -= I_IN;
        if (r < I_SQ) { const int kb = r / 32, n0 = 32 * (r % 32); transpose_item(w_out, 1024, (bf16*)(ws + WS_WOUT), 1024, 64 * kb, n0, n0, 64 * kb, scr, lane); continue; } r -= I_SQ;
        if (r < I_SQ) { const int kb = r / 32, n0 = 32 * (r % 32); transpose_item(wq, 1024, (bf16*)(ws + WS_WQ), 1024, 64 * kb, n0, n0, 64 * kb, scr, lane); continue; } r -= I_SQ;
        if (r < I_SQ) { const int kb = r / 32, n0 = 32 * (r % 32); transpose_item(wo, 1024, (bf16*)(ws + WS_WO), 1024, 64 * kb, n0, n0, 64 * kb, scr, lane); continue; } r -= I_SQ;
        if (r < I_KV) { const int kb = r / 64, n0 = 32 * (r % 64); transpose_item(wkv, 2048, (bf16*)(ws + WS_WKV), 1024, 64 * kb, n0, n0, 64 * kb, scr, lane); continue; } r -= I_KV;
        if (r < I_FI) { const int kb = r / 176, n0 = 32 * (r % 176); const int half = n0 / DFF, c = n0 % DFF; const int drow = (c / 128) * 256 + half * 128 + (c % 128);
            transpose_item(fin, 2 * DFF, (bf16*)(ws + WS_WFI), 1024, 64 * kb, n0, drow, 64 * kb, scr, lane); continue; } r -= I_FI;
        { const int kb = r / 32, n0 = 32 * (r % 32); const int k0 = 64 * kb;
          transpose_item(fout, 1024, (bf16*)(ws + WS_WFOA), DFF, k0, n0, n0, k0, scr, lane); }
    }
    bf16* wt = (bf16*)(ws + WS_WIN);
    for (int idx = gw * 64 + lane; idx < 16 * 1024; idx += NGW * 64) { const int j = idx & 15, k = idx >> 4; wt[(size_t)(nmain + j) * 1024 + k] = f2bf(w_in[(size_t)k * nin + nmain + j]); }
}
DI void to_bf16(const float* src, bf16* dst, size_t n, int gtid, int gthreads) {
    for (size_t i = (size_t)gtid * 8; i < n; i += (size_t)gthreads * 8) { const f32x4 a = *(const f32x4*)(src + i), b = *(const f32x4*)(src + i + 4);
        u32x4 o; o.x = cvtpk(a[0], a[1]); o.y = cvtpk(a[2], a[3]); o.z = cvtpk(b[0], b[1]); o.w = cvtpk(b[2], b[3]); *(u32x4*)(dst + i) = o; }
}
DI void rope_table(const int* pos, float* tab, int gtid, int gthreads) {
    for (int i = gtid; i < T * 8; i += gthreads) { const int t = i >> 3, f = i & 7;
        const float inv = exp2f(-(float)f * (18.931568569324174f / 8.f));
        const double ang = (double)((float)pos[t] * inv);
        double r = ang * 0.15915494309189535; r -= floor(r);
        const float rf = (float)r;
        tab[(size_t)t * 16 + f] = __builtin_amdgcn_cosf(rf); tab[(size_t)t * 16 + 8 + f] = __builtin_amdgcn_sinf(rf); }
}
DI void ln_apply(const float* y, const float* g, const float* bta, float* outf, bf16* outb, float* stats, int gw, int NGW, int lane) {
    f32x4 gv[4], bv[4];
#pragma unroll
    for (int j = 0; j < 4; ++j) { gv[j] = ((const f32x4*)g)[lane + 64 * j]; bv[j] = ((const f32x4*)bta)[lane + 64 * j]; }
    for (int m0 = 2 * gw; m0 < T; m0 += 2 * NGW) {
        f32x4 v[2][4]; float s[2] = {0.f, 0.f};
#pragma unroll
        for (int r = 0; r < 2; ++r) { const f32x4* xr = (const f32x4*)(y + (size_t)(m0 + r) * D) + lane;
#pragma unroll
            for (int j = 0; j < 4; ++j) v[r][j] = xr[64 * j]; }
#pragma unroll
        for (int r = 0; r < 2; ++r) {
#pragma unroll
            for (int j = 0; j < 4; ++j) s[r] += (v[r][j][0] + v[r][j][1]) + (v[r][j][2] + v[r][j][3]);
            const float mean = wave_sum(s[r]) * (1.f / D); float s2 = 0.f;
#pragma unroll
            for (int j = 0; j < 4; ++j) { v[r][j] = v[r][j] - mean; s2 += (v[r][j][0] * v[r][j][0] + v[r][j][1] * v[r][j][1]) + (v[r][j][2] * v[r][j][2] + v[r][j][3] * v[r][j][3]); }
            const float rstd = 1.f / sqrtf(wave_sum(s2) * (1.f / D) + 1e-5f);
            const size_t m = m0 + r;
            if (stats && lane == 0) { stats[2 * m] = mean; stats[2 * m + 1] = rstd; }
#pragma unroll
            for (int j = 0; j < 4; ++j) { const f32x4 o = v[r][j] * rstd * gv[j] + bv[j];
                if (!stats) ((f32x4*)(outf + m * D))[lane + 64 * j] = o;
                if (outb) { u32x2 w; w.x = cvtpk(o[0], o[1]); w.y = cvtpk(o[2], o[3]); ((u32x2*)(outb + m * D))[lane + 64 * j] = w; } }
        }
    }
}
DI bool so_next(const pg8::StaticOrder& S, int i, int& pm, int& pn) {
    const long Lx = (long)i * S.G + S.c; if (Lx >= S.nwg) return false;
    int wgid = (int)Lx; { const int q = S.nwg / pg8::NXCD, r = S.nwg % pg8::NXCD, xcd = wgid % pg8::NXCD, off = wgid / pg8::NXCD; wgid = (xcd < r ? xcd * (q + 1) : r * (q + 1) + (xcd - r) * q) + off; }
    const int nig = pg8::WGM * S.nN, gid = wgid / nig, fm = gid * pg8::WGM, gsz = (S.nM - fm) < pg8::WGM ? (S.nM - fm) : pg8::WGM;
    pm = fm + ((wgid % nig) % gsz); pn = (wgid % nig) / gsz; return true;
}
DI void ffn_fix(const float* RAW, bf16* Act, const float* cw, const float* cbias, int pm, int tid) {
    if ((pm & 7) == 0) return;
    for (int rem = tid; rem < 1408; rem += 512) {
        const int j = rem / 704, ch = 4 * (rem % 704);
        const float* x0 = RAW + ((size_t)pm * 4 + j) * 5632;
        const float* x1 = j == 0 ? RAW + ((size_t)(pm - 1) * 4 + 3) * 5632 : RAW + ((size_t)pm * 4 + 0) * 5632;
        const float* x2 = j == 0 ? RAW + ((size_t)(pm - 1) * 4 + 2) * 5632 : RAW + ((size_t)(pm - 1) * 4 + 3) * 5632;
        f32x4 cv[2];
#pragma unroll
        for (int bj = 0; bj < 2; ++bj) { const int col = bj * 2816 + ch;
            cv[bj] = *(const f32x4*)(cbias + col) + *(const f32x4*)(cw + 2 * 5632 + col) * *(const f32x4*)(x0 + col) + *(const f32x4*)(cw + 5632 + col) * *(const f32x4*)(x1 + col) + *(const f32x4*)(cw + col) * *(const f32x4*)(x2 + col); }
        u32x2 w; w.x = cvtpk(siluf(cv[0][0]) * cv[1][0], siluf(cv[0][1]) * cv[1][1]); w.y = cvtpk(siluf(cv[0][2]) * cv[1][2], siluf(cv[0][3]) * cv[1][3]);
        *(u32x2*)(Act + (size_t)(pm * 256 + j) * 2816 + ch) = w;
    }
}
DI void gate_cols(const bf16* A, const bf16* Wg, float* G16, int task) {
    const int lane = tid_() & 63, l31 = lane & 31, h = lane >> 5;
    const bf16* ap = A + (size_t)(32 * task + l31) * 1024 + 8 * h; const bf16* bp = Wg + (size_t)(l31 & 15) * 1024 + 8 * h;
    f32x16 c; zero16(c);
#pragma unroll 16
    for (int ks = 0; ks < 64; ++ks) { const bf16x8 a = *(const bf16x8*)(ap + 16 * ks); bf16x8 bb = *(const bf16x8*)(bp + 16 * ks);
        if (l31 >= 16) bb = (bf16x8){0, 0, 0, 0, 0, 0, 0, 0};
        c = MFMA32(a, bb, c); }
    if (l31 < 16) {
#pragma unroll
        for (int i = 0; i < 16; ++i) G16[(size_t)(32 * task + crow(i, h)) * 16 + l31] = c[i]; }
}
constexpr int DA_KS = 272, DA_VT = 144;
constexpr int DA_OFF_K = 0, DA_OFF_V = 64 * DA_KS, DA_OFF_C = DA_OFF_V + 128 * DA_VT;
DI void diffattn_unit(const bf16* Hin, const float* rope, const float* gnorm, bf16* Omix, LAS unsigned char* L, int b, int hh, int qb, float lam) {
    const int tid = tid_(), wave = __builtin_amdgcn_readfirstlane(tid >> 6), lane = tid & 63, l31 = lane & 31, h = lane >> 5;
    const int map = wave >> 2, wq = wave & 3;
    const int q0 = qb * 128 + wq * 32;
    const size_t tq = (size_t)b * SEQ + q0 + l31;
    bf16x8 qf[4];
    { const bf16* qrow = Hin + tq * 3072 + hh * 128 + map * 64;
#pragma unroll
      for (int ks = 1; ks < 4; ++ks) qf[ks] = *(const bf16x8*)(qrow + 16 * ks + 8 * h);
      float x1[8], x2[8], o[8]; unpack8(*(const u32x4*)qrow, x1); unpack8(*(const u32x4*)(qrow + 8), x2);
      const float* rt = rope + tq * 16;
#pragma unroll
      for (int j = 0; j < 8; ++j) { const float c = rt[j], s = rt[8 + j]; o[j] = h == 0 ? x1[j] * c - x2[j] * s : x2[j] * c + x1[j] * s; }
      qf[0] = __builtin_bit_cast(bf16x8, packf8(o)); }
    f32x16 o[4];
#pragma unroll
    for (int i = 0; i < 4; ++i) zero16(o[i]);
    float mrun = -INFINITY, lrun = 0.f;
    const float sc = 0.125f * LOG2E;
    const int kend = qb * 128 + 128;
    u32x4 pk[2], pp[2], pv[2]; f32x4 prc[2][2], prs[2][2];
#define DA_LOAD(kk) do { _Pragma("unroll") for (int i = 0; i < 2; ++i) { const int c = tid + 512 * i, key = c & 63, ch = c >> 6; const size_t tk = (size_t)b * SEQ + (kk) + key; \
        const bf16* krow = Hin + tk * 3072 + 512 + hh * 128; pk[i] = *(const u32x4*)(krow + 8 * ch); \
        if ((ch & 7) < 2) { pp[i] = *(const u32x4*)(krow + 8 * (ch ^ 1)); const f32x4* rt = (const f32x4*)(rope + tk * 16); prc[i][0] = rt[0]; prc[i][1] = rt[1]; prs[i][0] = rt[2]; prs[i][1] = rt[3]; } \
        pv[i] = *(const u32x4*)(Hin + tk * 3072 + 1024 + hh * 128 + 8 * ch); } } while (0)
    DA_LOAD(0);
    for (int k0 = 0; k0 < kend; k0 += 64) {
        LBAR();
#pragma unroll
        for (int i = 0; i < 2; ++i) { const int c = tid + 512 * i, key = c & 63, ch = c >> 6;
            u32x4 v = pk[i];
            if ((ch & 7) < 2) { float a[8], p[8], r[8]; unpack8(v, a); unpack8(pp[i], p);
#pragma unroll
                for (int j = 0; j < 8; ++j) { const float cc = prc[i][j >> 2][j & 3], sn = prs[i][j >> 2][j & 3]; r[j] = (ch & 1) == 0 ? a[j] * cc - p[j] * sn : a[j] * cc + p[j] * sn; }
                v = packf8(r); }
            *(LAS u32x4*)(L + DA_OFF_K + key * DA_KS + ch * 16) = v;
            const u32x4 vv = pv[i];
            LAS bf16* vt = (LAS bf16*)(L + DA_OFF_V + (8 * ch) * DA_VT + key * 2);
            vt[0 * (DA_VT / 2)] = (bf16)(vv.x & 0xffff); vt[1 * (DA_VT / 2)] = (bf16)(vv.x >> 16); vt[2 * (DA_VT / 2)] = (bf16)(vv.y & 0xffff); vt[3 * (DA_VT / 2)] = (bf16)(vv.y >> 16);
            vt[4 * (DA_VT / 2)] = (bf16)(vv.z & 0xffff); vt[5 * (DA_VT / 2)] = (bf16)(vv.z >> 16); vt[6 * (DA_VT / 2)] = (bf16)(vv.w & 0xffff); vt[7 * (DA_VT / 2)] = (bf16)(vv.w >> 16); }
        LBAR();
        if (k0 + 64 < kend) DA_LOAD(k0 + 64);
        if (k0 <= q0 + 31) {
            f32x16 st[2];
#pragma unroll
            for (int kt = 0; kt < 2; ++kt) { zero16(st[kt]);
#pragma unroll
                for (int ks = 0; ks < 4; ++ks) { const bf16x8 a = lds_rd16(L + DA_OFF_K + (32 * kt + l31) * DA_KS + (map * 64 + 16 * ks + 8 * h) * 2); st[kt] = MFMA32(a, qf[ks], st[kt]); } }
            const bool diag = (k0 + 63 > q0);
            float mx = -INFINITY;
            if (diag) {
#pragma unroll
                for (int kt = 0; kt < 2; ++kt)
#pragma unroll
                    for (int i = 0; i < 16; ++i) { if (k0 + 32 * kt + crow(i, h) > q0 + l31) st[kt][i] = -INFINITY; } }
#pragma unroll
            for (int kt = 0; kt < 2; ++kt)
#pragma unroll
                for (int i = 0; i < 16; ++i) mx = fmaxf(mx, st[kt][i]);
            mx = fmaxf(mx, __shfl_xor(mx, 32));
            const float mnew = fmaxf(mrun, mx), alpha = __builtin_amdgcn_exp2f((mrun - mnew) * sc), nm = -mnew * sc;
            float rs = 0.f;
#pragma unroll
            for (int kt = 0; kt < 2; ++kt)
#pragma unroll
                for (int i = 0; i < 16; ++i) { const float p = __builtin_amdgcn_exp2f(__builtin_fmaf(st[kt][i], sc, nm)); st[kt][i] = p; rs += p; }
            rs += __shfl_xor(rs, 32);
            lrun = lrun * alpha + rs; mrun = mnew;
            if (__ballot(alpha != 1.f) != 0ull) {
#pragma unroll
                for (int mt = 0; mt < 4; ++mt)
#pragma unroll
                    for (int i = 0; i < 16; ++i) o[mt][i] *= alpha; }
#pragma unroll
            for (int kt = 0; kt < 2; ++kt)
#pragma unroll
                for (int s2 = 0; s2 < 2; ++s2) { const bf16x8 pb = pack8(st[kt], s2);
#pragma unroll
                    for (int mt = 0; mt < 4; ++mt) { const bf16x8 a = lds_rd8x2(L + DA_OFF_V + (32 * mt + l31) * DA_VT + (32 * kt + 16 * s2 + 4 * h) * 2); o[mt] = MFMA32(a, pb, o[mt]); } }
        }
    }
    const float inv = (map == 0 ? 1.f : lam) / lrun;
    LAS float* cbuf = (LAS float*)(L + DA_OFF_C) + wq * 4096 + lane;
    if (map == 1) {
#pragma unroll
        for (int mt = 0; mt < 4; ++mt)
#pragma unroll
            for (int i = 0; i < 16; ++i) cbuf[(mt * 16 + i) * 64] = o[mt][i] * inv;
    }
    __syncthreads();
    if (map == 0) {
        float ss = 0.f;
#pragma unroll
        for (int mt = 0; mt < 4; ++mt)
#pragma unroll
            for (int i = 0; i < 16; ++i) { const float v = o[mt][i] * inv - cbuf[(mt * 16 + i) * 64]; o[mt][i] = v; ss += v * v; }
        ss += __shfl_xor(ss, 32);
        const float r = rsqrtf(ss * (1.f / 128.f) + 1e-6f) * 0.8f;
        bf16* orow = Omix + tq * 1024 + hh * 128;
#pragma unroll
        for (int mt = 0; mt < 4; ++mt)
#pragma unroll
            for (int g4 = 0; g4 < 4; ++g4) { const int dv = 32 * mt + 8 * g4 + 4 * h; const f32x4 gn = *(const f32x4*)(gnorm + dv);
                u32x2 w; w.x = cvtpk(o[mt][4 * g4] * r * gn[0], o[mt][4 * g4 + 1] * r * gn[1]); w.y = cvtpk(o[mt][4 * g4 + 2] * r * gn[2], o[mt][4 * g4 + 3] * r * gn[3]);
                *(u32x2*)(orow + dv) = w; }
    }
}
constexpr int GL_QS = 0, GL_KS = 64 * 144, GL_KH = 2 * 64 * 144, GL_VT = 3 * 64 * 144, GL_ST = GL_VT + 128 * 144, GL_TOT = GL_ST + 128 * 144, GL_BL = GL_TOT + 8 * 64 * 4, GL_SS = GL_BL + 256;
#define GLA_GATES(bl, tot) \
    float bl[8]; float tot = 0.f; { float run = 0.f; \
        _Pragma("unroll") for (int j = 0; j < 8; ++j) { const f32x4* gl = (const f32x4*)(G16 + (t0 + 8 * wave + j) * 16); float x = b2r; \
            _Pragma("unroll") for (int r4 = 0; r4 < 4; ++r4) { const f32x4 gq = gl[r4]; x += gq[0] * w2r[4 * r4] + gq[1] * w2r[4 * r4 + 1] + gq[2] * w2r[4 * r4 + 2] + gq[3] * w2r[4 * r4 + 3]; } \
            const float ls = fminf(x, 0.f) - __logf(1.f + __expf(-fabsf(x))); run += ls * (1.f / 16.f); bl[j] = run; } \
        __syncthreads(); \
        ((LAS float*)(L + GL_TOT))[wave * 64 + lane] = run; \
        __syncthreads(); \
        float pre = 0.f; \
        _Pragma("unroll") for (int w = 0; w < 8; ++w) { const float x = ((LAS float*)(L + GL_TOT))[w * 64 + lane]; tot += x; if (w < wave) pre += x; } \
        _Pragma("unroll") for (int j = 0; j < 8; ++j) bl[j] += pre; }
#define GLA_STAGE_VT() \
    _Pragma("unroll") for (int i = 0; i < 2; ++i) { const int c = tid + 512 * i, key = c & 63, ch = c >> 6; \
        const u32x4 vv = *(const u32x4*)(Hin + (t0 + key) * 3072 + 2048 + hh * 128 + 8 * ch); \
        LAS bf16* vtp = (LAS bf16*)(L + GL_VT + (8 * ch) * 144 + key * 2); \
        vtp[0 * 72] = (bf16)(vv.x & 0xffff); vtp[1 * 72] = (bf16)(vv.x >> 16); vtp[2 * 72] = (bf16)(vv.y & 0xffff); vtp[3 * 72] = (bf16)(vv.y >> 16); \
        vtp[4 * 72] = (bf16)(vv.z & 0xffff); vtp[5 * 72] = (bf16)(vv.z >> 16); vtp[6 * 72] = (bf16)(vv.w & 0xffff); vtp[7 * 72] = (bf16)(vv.w >> 16); }
DI void gla_passA_unit(const bf16* Hin, const float* G16, const float* w2, const float* b2, float* LOC, float* DEC, LAS unsigned char* L, int b, int hh, int n) {
    const int tid = tid_(), wave = __builtin_amdgcn_readfirstlane(tid >> 6), lane = tid & 63, l31 = lane & 31, h = lane >> 5;
    const int vt = wave & 3, tt = wave >> 2;
    float w2r[16];
#pragma unroll
    for (int r = 0; r < 16; ++r) w2r[r] = w2[r * 256 + hh * 64 + lane];
    const float b2r = b2[hh * 64 + lane];
    const size_t t0 = (size_t)b * SEQ + 64 * n;
    const int unit = (b * 4 + hh) * 32 + n;
    GLA_GATES(bl, tot)
    if (wave == 0) DEC[(size_t)unit * 64 + lane] = __expf(tot);
#pragma unroll
    for (int j = 0; j < 8; ++j) { const int t = 8 * wave + j;
        const float kv = bf2f(Hin[(t0 + t) * 3072 + 1792 + hh * 64 + lane]);
        ((LAS bf16*)(L + GL_KH + lane * 144))[t] = f2bf(kv * __expf(tot - bl[j])); }
    GLA_STAGE_VT()
    __syncthreads();
    f32x16 S; zero16(S);
#pragma unroll
    for (int ks = 0; ks < 4; ++ks) { const bf16x8 a = lds_rd16(L + GL_VT + (32 * vt + l31) * 144 + (16 * ks + 8 * h) * 2); const bf16x8 bb = lds_rd16(L + GL_KH + (32 * tt + l31) * 144 + (16 * ks + 8 * h) * 2); S = MFMA32(a, bb, S); }
    float* loc = LOC + (size_t)unit * 8192;
#pragma unroll
    for (int i = 0; i < 16; ++i) loc[(32 * vt + crow(i, h)) * 64 + 32 * tt + l31] = S[i];
}
DI void gla_passB(const float* LOC, const float* DEC, bf16* SST, int bh, int slice) {
    const int tid = tid_();
    const int e = slice * 1024 + tid * 2, d = e & 63;
    float s0 = 0.f, s1 = 0.f;
#pragma unroll 8
    for (int n = 0; n < 32; ++n) { const size_t unit = (size_t)bh * 32 + n;
        *(unsigned*)(SST + unit * 8192 + e) = cvtpk(s0, s1);
        const float2 l = *(const float2*)(LOC + unit * 8192 + e), dc = *(const float2*)(DEC + unit * 64 + d);
        s0 = s0 * dc.x + l.x; s1 = s1 * dc.y + l.y; }
}
DI void gla_passC_unit(const bf16* Hin, const float* G16, const float* w2, const float* b2, const float* gnorm, const bf16* SST, bf16* Omix, LAS unsigned char* L, int b, int hh, int n) {
    const int tid = tid_(), wave = __builtin_amdgcn_readfirstlane(tid >> 6), lane = tid & 63, l31 = lane & 31, h = lane >> 5;
    const int vt = wave & 3, tt = wave >> 2;
    float w2r[16];
#pragma unroll
    for (int r = 0; r < 16; ++r) w2r[r] = w2[r * 256 + hh * 64 + lane];
    const float b2r = b2[hh * 64 + lane];
    const size_t t0 = (size_t)b * SEQ + 64 * n;
    const int unit = (b * 4 + hh) * 32 + n;
    GLA_GATES(bl, tot)
    (void)tot;
#pragma unroll
    for (int j = 0; j < 8; ++j) { const int t = 8 * wave + j; const float bb = bl[j];
        const float qv = bf2f(Hin[(t0 + t) * 3072 + 1536 + hh * 64 + lane]), kv = bf2f(Hin[(t0 + t) * 3072 + 1792 + hh * 64 + lane]);
        ((LAS bf16*)(L + GL_QS + t * 144))[lane] = f2bf(qv * 0.125f * __expf(bb));
        ((LAS bf16*)(L + GL_KS + t * 144))[lane] = f2bf(kv * __expf(-bb)); }
    GLA_STAGE_VT()
#pragma unroll
    for (int i = 0; i < 2; ++i) { const int c = tid + 512 * i, v = c >> 3, ch = c & 7;
        *(LAS u32x4*)(L + GL_ST + v * 144 + ch * 16) = *(const u32x4*)(SST + (size_t)unit * 8192 + v * 64 + 8 * ch); }
    __syncthreads();
    bf16x8 qf[4];
#pragma unroll
    for (int ks = 0; ks < 4; ++ks) qf[ks] = lds_rd16(L + GL_QS + (32 * tt + l31) * 144 + (16 * ks + 8 * h) * 2);
    f32x16 at[2];
#pragma unroll
    for (int st = 0; st < 2; ++st) { zero16(at[st]);
#pragma unroll
        for (int ks = 0; ks < 4; ++ks) { const bf16x8 a = lds_rd16(L + GL_KS + (32 * st + l31) * 144 + (16 * ks + 8 * h) * 2); at[st] = MFMA32(a, qf[ks], at[st]); }
#pragma unroll
        for (int i = 0; i < 16; ++i) if (32 * st + crow(i, h) > 32 * tt + l31) at[st][i] = 0.f; }
    f32x16 oT; zero16(oT);
#pragma unroll
    for (int ks = 0; ks < 4; ++ks) { const bf16x8 a = lds_rd16(L + GL_ST + (32 * vt + l31) * 144 + (16 * ks + 8 * h) * 2); oT = MFMA32(a, qf[ks], oT); }
#pragma unroll
    for (int st = 0; st < 2; ++st)
#pragma unroll
        for (int s2 = 0; s2 < 2; ++s2) { const bf16x8 pb = pack8(at[st], s2); const bf16x8 a = lds_rd8x2(L + GL_VT + (32 * vt + l31) * 144 + (32 * st + 16 * s2 + 4 * h) * 2); oT = MFMA32(a, pb, oT); }
    float ss = 0.f;
#pragma unroll
    for (int i = 0; i < 16; ++i) ss += oT[i] * oT[i];
    ss += __shfl_xor(ss, 32);
    if (h == 0) ((LAS float*)(L + GL_SS))[wave * 32 + l31] = ss;
    __syncthreads();
    float tot2 = 0.f;
#pragma unroll
    for (int w = 0; w < 4; ++w) tot2 += ((LAS float*)(L + GL_SS))[(4 * tt + w) * 32 + l31];
    const float r = rsqrtf(tot2 * (1.f / 128.f) + 1e-6f);
    const size_t trow = t0 + 32 * tt + l31;
#pragma unroll
    for (int g4 = 0; g4 < 4; ++g4) { const int dv = 32 * vt + 8 * g4 + 4 * h; const f32x4 gn = *(const f32x4*)(gnorm + dv);
        const u32x2 rr = *(const u32x2*)(Hin + trow * 3072 + 2560 + hh * 128 + dv);
        const float r0 = siluf(bflo(rr.x)), r1 = siluf(bfhi(rr.x)), r2 = siluf(bflo(rr.y)), r3 = siluf(bfhi(rr.y));
        u32x2 w; w.x = cvtpk(oT[4 * g4] * r * gn[0] * r0, oT[4 * g4 + 1] * r * gn[1] * r1); w.y = cvtpk(oT[4 * g4 + 2] * r * gn[2] * r2, oT[4 * g4 + 3] * r * gn[3] * r3);
        *(u32x2*)(Omix + trow * 1024 + 512 + hh * 128 + dv) = w; }
}
constexpr int XA_KS = 528, XA_VT = 144, XA_OFF_V = 64 * XA_KS;
DI void xattn_unit(const bf16* Q, const bf16* KVm, bf16* Oxa, LAS unsigned char* L, int b, int hd, int qb) {
    const int tid = tid_(), wave = __builtin_amdgcn_readfirstlane(tid >> 6), lane = tid & 63, l31 = lane & 31, h = lane >> 5;
    const size_t tq = (size_t)b * SEQ + qb * 256 + wave * 32 + l31;
    f32x16 st[8];
    u32x4 pk[4];
#define XA_KLOAD(kb_) do { _Pragma("unroll") for (int i = 0; i < 4; ++i) { const int c = tid + 512 * i, key = c >> 5, ch = c & 31; \
        pk[i] = *(const u32x4*)(KVm + (size_t)(b * 256 + (kb_) * 64 + key) * 2048 + hd * 256 + 8 * ch); } } while (0)
    XA_KLOAD(0);
#pragma unroll
    for (int kb = 0; kb < 4; ++kb) {
        LBAR();
#pragma unroll
        for (int i = 0; i < 4; ++i) { const int c = tid + 512 * i, key = c >> 5, ch = c & 31; *(LAS u32x4*)(L + key * XA_KS + ch * 16) = pk[i]; }
        LBAR();
        if (kb < 3) XA_KLOAD(kb + 1);
        zero16(st[2 * kb]); zero16(st[2 * kb + 1]);
#pragma unroll
        for (int hf = 0; hf < 2; ++hf) { bf16x8 qf[8];
#pragma unroll
            for (int ks = 0; ks < 8; ++ks) qf[ks] = *(const bf16x8*)(Q + tq * 1024 + hd * 256 + 16 * (8 * hf + ks) + 8 * h);
#pragma unroll
            for (int kt = 0; kt < 2; ++kt)
#pragma unroll
                for (int ks = 0; ks < 8; ++ks) { const bf16x8 a = lds_rd16(L + (32 * kt + l31) * XA_KS + (16 * (8 * hf + ks) + 8 * h) * 2); st[2 * kb + kt] = MFMA32(a, qf[ks], st[2 * kb + kt]); }
            asm volatile("" ::: "memory"); }
    }
    u32x4 pv[2];
#define XA_VLOAD(s_) do { _Pragma("unroll") for (int i = 0; i < 2; ++i) { const int c = tid + 512 * i, key = c & 63, ch = c >> 6; \
        pv[i] = *(const u32x4*)(KVm + (size_t)(b * 256 + ((s_) & 3) * 64 + key) * 2048 + 1024 + hd * 256 + ((s_) >> 2) * 128 + 8 * ch); } } while (0)
    XA_VLOAD(0);
    const float sc = 0.0625f * LOG2E;
    float mx = -INFINITY;
#pragma unroll
    for (int j = 0; j < 8; ++j)
#pragma unroll
        for (int i = 0; i < 16; ++i) mx = fmaxf(mx, st[j][i]);
    mx = fmaxf(mx, __shfl_xor(mx, 32));
    const float nmx = -mx * sc;
    float rs = 0.f;
#pragma unroll
    for (int j = 0; j < 8; ++j)
#pragma unroll
        for (int i = 0; i < 16; ++i) { const float p = __builtin_amdgcn_exp2f(__builtin_fmaf(st[j][i], sc, nmx)); st[j][i] = p; rs += p; }
    rs += __shfl_xor(rs, 32);
    const float inv = 1.f / rs;
    bf16x8 pb[8][2];
#pragma unroll
    for (int j = 0; j < 8; ++j) {
#pragma unroll
        for (int i = 0; i < 16; ++i) st[j][i] *= inv;
        pb[j][0] = pack8(st[j], 0); pb[j][1] = pack8(st[j], 1); }
    f32x16 o[4];
#pragma unroll
    for (int s8 = 0; s8 < 8; ++s8) {
        const int dvh = s8 >> 2, kb = s8 & 3;
        if (kb == 0) {
#pragma unroll
            for (int mt = 0; mt < 4; ++mt) zero16(o[mt]); }
        LBAR();
#pragma unroll
        for (int i = 0; i < 2; ++i) { const int c = tid + 512 * i, key = c & 63, ch = c >> 6; const u32x4 vv = pv[i];
            LAS bf16* vtp = (LAS bf16*)(L + XA_OFF_V + (8 * ch) * XA_VT + key * 2);
            vtp[0 * 72] = (bf16)(vv.x & 0xffff); vtp[1 * 72] = (bf16)(vv.x >> 16); vtp[2 * 72] = (bf16)(vv.y & 0xffff); vtp[3 * 72] = (bf16)(vv.y >> 16);
            vtp[4 * 72] = (bf16)(vv.z & 0xffff); vtp[5 * 72] = (bf16)(vv.z >> 16); vtp[6 * 72] = (bf16)(vv.w & 0xffff); vtp[7 * 72] = (bf16)(vv.w >> 16); }
        LBAR();
        if (s8 < 7) XA_VLOAD(s8 + 1);
#pragma unroll
        for (int mt = 0; mt < 4; ++mt)
#pragma unroll
            for (int kt = 0; kt < 2; ++kt)
#pragma unroll
                for (int s2 = 0; s2 < 2; ++s2) { const bf16x8 a = lds_rd8x2(L + XA_OFF_V + (32 * mt + l31) * XA_VT + (32 * kt + 16 * s2 + 4 * h) * 2); o[mt] = MFMA32(a, pb[2 * kb + kt][s2], o[mt]); }
        if (kb == 3) {
            bf16* orow = Oxa + tq * 1024 + hd * 256 + dvh * 128;
#pragma unroll
            for (int mt = 0; mt < 4; ++mt)
#pragma unroll
                for (int g4 = 0; g4 < 4; ++g4) { const int dv = 32 * mt + 8 * g4 + 4 * h;
                    u32x2 w; w.x = cvtpk(o[mt][4 * g4], o[mt][4 * g4 + 1]); w.y = cvtpk(o[mt][4 * g4 + 2], o[mt][4 * g4 + 3]); *(u32x2*)(orow + dv) = w; } }
    }
}
constexpr int GP_KN = 0, GP_M = 64 * 272, GP_U0 = GP_M + 64 * 68 * 4, GP_W0 = GP_U0 + 64 * 128 * 4, GP_GT = GP_W0 + 64 * 128 * 4;
DI void gdn_prep_unit(bf16* Hin, float* G16, const bf16* halo, const float* convw, const float* a_log, const float* dt_bias, bf16* Wb, LAS unsigned char* L, int b, int n, int hd, bool dry, unsigned* flag) {
    const int tid = tid_(), wave = __builtin_amdgcn_readfirstlane(tid >> 6), lane = tid & 63, l31 = lane & 31, h = lane >> 5;
    const size_t t0 = (size_t)b * SEQ + 64 * n;
    LAS float* gt = (LAS float*)(L + GP_GT);
    const int c8 = tid & 15, tr = tid >> 4;
    u32x4 raw[3][2][4];
#pragma unroll
    for (int which = 0; which < 3; ++which) { const int col = which * 1024 + hd * 128 + 8 * c8;
#pragma unroll
        for (int rr = 0; rr < 2; ++rr)
#pragma unroll
            for (int j = 0; j < 4; ++j) { const int ts = tr + 32 * rr - 3 + j; u32x4 v = {0u, 0u, 0u, 0u};
                if (ts >= 0) v = *(const u32x4*)(Hin + (t0 + ts) * 4096 + col);
                else if (n > 0) v = *(const u32x4*)(halo + ((size_t)(b * 32 + n - 1) * 3 + (ts + 3)) * 3072 + col);
                raw[which][rr][j] = v; } }
    float blv = 0.f, alv = 0.f;
    if (wave == 0) { blv = G16[(t0 + lane) * 16 + hd]; alv = G16[(t0 + lane) * 16 + 8 + hd]; }
    LBAR();
    if (wave == 0) {
        const float x = alv + dt_bias[hd];
        const float sp = fmaxf(x, 0.f) + __logf(1.f + __expf(-fabsf(x)));
        float g = -__expf(a_log[hd]) * sp;
#pragma unroll
        for (int o = 1; o < 64; o <<= 1) { const float y = __shfl_up(g, o); if (lane >= o) g += y; }
        gt[lane] = sigmoidf_(blv); gt[64 + lane] = g;
        if (!dry) __hip_atomic_store(G16 + (t0 + lane) * 16 + hd, g, __ATOMIC_RELAXED, __HIP_MEMORY_SCOPE_AGENT);
    }
    float res[2][3][8];
#pragma unroll
    for (int which = 0; which < 3; ++which) {
        const int col = which * 1024 + hd * 128 + 8 * c8;
        float wv[4][8];
#pragma unroll
        for (int j = 0; j < 4; ++j) { const f32x4 a = *(const f32x4*)(convw + (size_t)j * 3072 + col), bb = *(const f32x4*)(convw + (size_t)j * 3072 + col + 4);
#pragma unroll
            for (int e = 0; e < 4; ++e) { wv[j][e] = a[e]; wv[j][4 + e] = bb[e]; } }
#pragma unroll
        for (int rr = 0; rr < 2; ++rr) { float acc[8];
#pragma unroll
            for (int e = 0; e < 8; ++e) acc[e] = 0.f;
#pragma unroll
            for (int j = 0; j < 4; ++j) { float xf[8]; unpack8(raw[which][rr][j], xf);
#pragma unroll
                for (int e = 0; e < 8; ++e) acc[e] += wv[j][e] * xf[e]; }
#pragma unroll
            for (int e = 0; e < 8; ++e) res[rr][which][e] = siluf(acc[e]); }
    }
#pragma unroll
    for (int rr = 0; rr < 2; ++rr)
#pragma unroll
        for (int which = 0; which < 2; ++which) { float ss = 0.f;
#pragma unroll
            for (int e = 0; e < 8; ++e) ss += res[rr][which][e] * res[rr][which][e];
            ss += __shfl_xor(ss, 1); ss += __shfl_xor(ss, 2); ss += __shfl_xor(ss, 4); ss += __shfl_xor(ss, 8);
            const float r = rsqrtf(ss + 1e-6f) * (which == 0 ? 0.08838834764831845f : 1.f);
#pragma unroll
            for (int e = 0; e < 8; ++e) res[rr][which][e] *= r; }
    LBAR();
#pragma unroll
    for (int rr = 0; rr < 2; ++rr) { const int t = tr + 32 * rr; const float beta = gt[t], eg = __expf(gt[64 + t]);
        if (!dry) st16_wt(Hin + (t0 + t) * 4096 + hd * 128 + 8 * c8, packf8(res[rr][0]));
        const u32x4 kp = packf8(res[rr][1]);
        if (!dry) st16_wt(Hin + (t0 + t) * 4096 + 1024 + hd * 128 + 8 * c8, kp);
        *(LAS u32x4*)(L + GP_KN + t * 272 + c8 * 16) = kp;
        float kq[8]; unpack8(kp, kq);
        f32x4 u0a, u0b, w0a, w0b;
#pragma unroll
        for (int e = 0; e < 4; ++e) { u0a[e] = res[rr][2][e] * beta; u0b[e] = res[rr][2][4 + e] * beta; w0a[e] = kq[e] * beta * eg; w0b[e] = kq[4 + e] * beta * eg; }
        *(LAS f32x4*)(L + GP_U0 + (t * 128 + 8 * c8) * 4) = u0a; *(LAS f32x4*)(L + GP_U0 + (t * 128 + 8 * c8 + 4) * 4) = u0b;
        *(LAS f32x4*)(L + GP_W0 + (t * 128 + 8 * c8) * 4) = w0a; *(LAS f32x4*)(L + GP_W0 + (t * 128 + 8 * c8 + 4) * 4) = w0b; }
    LBAR();
    if (wave < 4) { const int mt = wave >> 1, nt = wave & 1; f32x16 c; zero16(c);
        if (!(mt == 0 && nt == 1)) {
#pragma unroll
            for (int ks = 0; ks < 8; ++ks) { const bf16x8 a = lds_rd16(L + GP_KN + (32 * mt + l31) * 272 + (16 * ks + 8 * h) * 2); const bf16x8 bb = lds_rd16(L + GP_KN + (32 * nt + l31) * 272 + (16 * ks + 8 * h) * 2); c = MFMA32(a, bb, c); } }
        const int s = 32 * nt + l31; const float gs = gt[64 + s];
#pragma unroll
        for (int g4 = 0; g4 < 4; ++g4) { f32x4 mv;
#pragma unroll
            for (int e = 0; e < 4; ++e) { const int t = 32 * mt + 8 * g4 + 4 * h + e; mv[e] = (s < t) ? gt[t] * c[4 * g4 + e] * __expf(gt[64 + t] - gs) : 0.f; }
            *(LAS f32x4*)(L + GP_M + (s * 68 + 32 * mt + 8 * g4 + 4 * h) * 4) = mv; } }
    LBAR();
    if (tid < 256) {
        LAS float* rhs = (LAS float*)(L + (tid < 128 ? GP_U0 : GP_W0)) + (tid & 127);
        float r[64];
#pragma unroll
        for (int t = 0; t < 64; ++t) r[t] = rhs[t * 128];
#pragma unroll
        for (int s0 = 0; s0 < 63; ++s0) { if ((s0 & 3) == 0) asm volatile("" ::: "memory");
            const float xs = r[s0];
#pragma unroll
            for (int q4 = (s0 + 1) / 4; q4 < 16; ++q4) { const f32x4 m = *(LAS const f32x4*)(L + GP_M + (s0 * 68 + 4 * q4) * 4);
                r[4 * q4] -= m[0] * xs; r[4 * q4 + 1] -= m[1] * xs; r[4 * q4 + 2] -= m[2] * xs; r[4 * q4 + 3] -= m[3] * xs; } }
#pragma unroll
        for (int t = 0; t < 64; ++t) rhs[t * 128] = r[t];
    }
    LBAR();
#pragma unroll 1
    for (int i = 0; i < 2; ++i) { const int c = tid + 512 * i, t = c >> 4, ch = c & 15;
        float f[8];
#pragma unroll
        for (int e = 0; e < 8; ++e) f[e] = ((LAS const float*)(L + GP_U0))[t * 128 + 8 * ch + e];
        if (!dry) st16_wt(Hin + (t0 + t) * 4096 + 2048 + hd * 128 + 8 * ch, packf8(f));
#pragma unroll
        for (int e = 0; e < 8; ++e) f[e] = ((LAS const float*)(L + GP_W0))[t * 128 + 8 * ch + e];
        if (!dry) st16_wt(Wb + (t0 + t) * 1024 + hd * 128 + 8 * ch, packf8(f)); }
    if (flag != nullptr) {
        asm volatile("s_waitcnt vmcnt(0)" ::: "memory");
        __syncthreads();
        if (tid == 0) __hip_atomic_store(flag, 1u, __ATOMIC_RELAXED, __HIP_MEMORY_SCOPE_AGENT);
    }
}
constexpr int GS_W = 0, GS_Q = 64 * 272, GS_K = 2 * 64 * 272, GS_KG = 3 * 64 * 272, GS_ST = GS_KG + 128 * 144, GS_VN = GS_ST + 128 * 272, GS_GC = GS_VN + 128 * 144, GS_SS = GS_GC + 256;
#define GS_LOAD(nn) do { const size_t t0n = (size_t)b * SEQ + 64 * (nn); \
    _Pragma("unroll") for (int i = 0; i < 2; ++i) { const int c = tid + 512 * i, t = c & 63, ch = c >> 6; \
        pw[i] = *(const u32x4*)(Wb + (t0n + t) * 1024 + hd * 128 + 8 * ch); pq[i] = *(const u32x4*)(Hin + (t0n + t) * 4096 + hd * 128 + 8 * ch); \
        pk[i] = *(const u32x4*)(Hin + (t0n + t) * 4096 + 1024 + hd * 128 + 8 * ch); pgk[i] = G16[(t0n + t) * 16 + hd]; } \
    pgc = G16[(t0n + (tid & 63)) * 16 + hd]; pgl = G16[(t0n + 63) * 16 + hd]; \
    { const size_t trn = t0n + 32 * tt + l31; \
      _Pragma("unroll") for (int g4 = 0; g4 < 4; ++g4) { pu[g4] = *(const u32x2*)(Hin + trn * 4096 + 2048 + hd * 128 + 32 * vt + 8 * g4 + 4 * h); pz[g4] = *(const u32x2*)(Hin + trn * 4096 + 3072 + hd * 128 + 32 * vt + 8 * g4 + 4 * h); } } } while (0)
DI void gdn_scan_unit(bf16* Hin, const float* G16, const bf16* Wb, const float* gnorm, LAS unsigned char* L, int b, int hd, bool dry, unsigned* flags) {
    const int tid = tid_(), wave = __builtin_amdgcn_readfirstlane(tid >> 6), lane = tid & 63, l31 = lane & 31, h = lane >> 5;
    const int vt = wave & 3, tt = wave >> 2;
    f32x16 S[2]; zero16(S[0]); zero16(S[1]);
    __syncthreads();
    for (int i = tid; i < 128 * 272 / 4; i += 512) ((LAS unsigned*)(L + GS_ST))[i] = 0u;
    LAS float* gcs = (LAS float*)(L + GS_GC);
    u32x4 pw[2], pq[2], pk[2]; float pgk[2], pgc, pgl; u32x2 pu[4], pz[4];
#define GS_WAIT(nn) do { if (flags != nullptr && tid == 0) { unsigned* f_ = flags + (b * 8 + hd) * 32 + (nn); unsigned sp_ = 0; \
        while (__hip_atomic_load(f_, __ATOMIC_RELAXED, __HIP_MEMORY_SCOPE_AGENT) == 0u) { __builtin_amdgcn_s_sleep(2); if (++sp_ > (1u << 24)) break; } \
        __builtin_amdgcn_fence(__ATOMIC_ACQUIRE, "agent"); asm volatile("s_waitcnt vmcnt(0)" ::: "memory"); } } while (0)
    GS_WAIT(0);
    __syncthreads();
    GS_LOAD(0);
    for (int n = 0; n < 32; ++n) {
        const size_t t0 = (size_t)b * SEQ + 64 * n;
        if (n < 31) GS_WAIT(n + 1);
        LBAR();
        const float gl = pgl;
        if (tid < 64) gcs[tid] = pgc;
#pragma unroll
        for (int i = 0; i < 2; ++i) { const int c = tid + 512 * i, t = c & 63, ch = c >> 6;
            *(LAS u32x4*)(L + GS_W + t * 272 + ch * 16) = pw[i];
            *(LAS u32x4*)(L + GS_Q + t * 272 + ch * 16) = pq[i];
            *(LAS u32x4*)(L + GS_K + t * 272 + ch * 16) = pk[i];
            float kf[8]; unpack8(pk[i], kf); const float e = __expf(gl - pgk[i]);
            LAS bf16* kg = (LAS bf16*)(L + GS_KG + (8 * ch) * 144 + t * 2);
#pragma unroll
            for (int j = 0; j < 8; ++j) kg[j * 72] = f2bf(kf[j] * e); }
        u32x2 cu[4], cz[4];
#pragma unroll
        for (int g4 = 0; g4 < 4; ++g4) { cu[g4] = pu[g4]; cz[g4] = pz[g4]; }
        LBAR();
        if (n < 31) GS_LOAD(n + 1);
        f32x16 vn; zero16(vn);
#pragma unroll
        for (int ks = 0; ks < 8; ++ks) { const bf16x8 a = lds_rd16(L + GS_ST + (32 * vt + l31) * 272 + (16 * ks + 8 * h) * 2); const bf16x8 bb = lds_rd16(L + GS_W + (32 * tt + l31) * 272 + (16 * ks + 8 * h) * 2); vn = MFMA32(a, bb, vn); }
#pragma unroll
        for (int g4 = 0; g4 < 4; ++g4) { const u32x2 uu = cu[g4];
            vn[4 * g4] = bflo(uu.x) - vn[4 * g4]; vn[4 * g4 + 1] = bfhi(uu.x) - vn[4 * g4 + 1]; vn[4 * g4 + 2] = bflo(uu.y) - vn[4 * g4 + 2]; vn[4 * g4 + 3] = bfhi(uu.y) - vn[4 * g4 + 3]; }
#pragma unroll
        for (int i = 0; i < 16; ++i) ((LAS bf16*)(L + GS_VN + (32 * vt + crow(i, h)) * 144))[32 * tt + l31] = f2bf(vn[i]);
        bf16x8 qf[8];
#pragma unroll
        for (int ks = 0; ks < 8; ++ks) qf[ks] = lds_rd16(L + GS_Q + (32 * tt + l31) * 272 + (16 * ks + 8 * h) * 2);
        const float gct = gcs[32 * tt + l31];
        f32x16 X[2];
#pragma unroll
        for (int st = 0; st < 2; ++st) { zero16(X[st]);
#pragma unroll
            for (int ks = 0; ks < 8; ++ks) { const bf16x8 a = lds_rd16(L + GS_K + (32 * st + l31) * 272 + (16 * ks + 8 * h) * 2); X[st] = MFMA32(a, qf[ks], X[st]); }
#pragma unroll
            for (int i = 0; i < 16; ++i) { const int s = 32 * st + crow(i, h); X[st][i] = (s <= 32 * tt + l31) ? X[st][i] * __expf(gct - gcs[s]) : 0.f; } }
        f32x16 oT; zero16(oT);
#pragma unroll
        for (int ks = 0; ks < 8; ++ks) { const bf16x8 a = lds_rd16(L + GS_ST + (32 * vt + l31) * 272 + (16 * ks + 8 * h) * 2); oT = MFMA32(a, qf[ks], oT); }
        { const float eg = __expf(gct);
#pragma unroll
          for (int i = 0; i < 16; ++i) oT[i] *= eg; }
        LBAR();
#pragma unroll
        for (int st = 0; st < 2; ++st)
#pragma unroll
            for (int s2 = 0; s2 < 2; ++s2) { const bf16x8 pb = pack8(X[st], s2); const bf16x8 a = lds_rd8x2(L + GS_VN + (32 * vt + l31) * 144 + (32 * st + 16 * s2 + 4 * h) * 2); oT = MFMA32(a, pb, oT); }
        float ss = 0.f;
#pragma unroll
        for (int i = 0; i < 16; ++i) ss += oT[i] * oT[i];
        ss += __shfl_xor(ss, 32);
        if (h == 0) ((LAS float*)(L + GS_SS))[wave * 32 + l31] = ss;
        { const float eg = __expf(gl);
#pragma unroll
          for (int j = 0; j < 2; ++j) {
#pragma unroll
              for (int i = 0; i < 16; ++i) S[j][i] *= eg;
#pragma unroll
              for (int ks = 0; ks < 4; ++ks) { const bf16x8 a = lds_rd16(L + GS_VN + (32 * vt + l31) * 144 + (16 * ks + 8 * h) * 2); const bf16x8 bb = lds_rd16(L + GS_KG + (32 * (2 * tt + j) + l31) * 144 + (16 * ks + 8 * h) * 2); S[j] = MFMA32(a, bb, S[j]); } } }
        LBAR();
        { float tot2 = 0.f;
#pragma unroll
          for (int w = 0; w < 4; ++w) tot2 += ((LAS float*)(L + GS_SS))[(4 * tt + w) * 32 + l31];
          const float r = rsqrtf(tot2 * (1.f / 128.f) + 1e-6f);
          const size_t trow = t0 + 32 * tt + l31;
#pragma unroll
          for (int g4 = 0; g4 < 4; ++g4) { const int dv = 32 * vt + 8 * g4 + 4 * h; const f32x4 gn = *(const f32x4*)(gnorm + dv);
              bf16* zp = Hin + trow * 4096 + 3072 + hd * 128 + dv;
              const u32x2 zz = cz[g4];
              const float z0 = siluf(bflo(zz.x)), z1 = siluf(bfhi(zz.x)), z2 = siluf(bflo(zz.y)), z3 = siluf(bfhi(zz.y));
              u32x2 w; w.x = cvtpk(oT[4 * g4] * r * gn[0] * z0, oT[4 * g4 + 1] * r * gn[1] * z1); w.y = cvtpk(oT[4 * g4 + 2] * r * gn[2] * z2, oT[4 * g4 + 3] * r * gn[3] * z3);
              if (!dry) *(u32x2*)zp = w; }
#pragma unroll
          for (int j = 0; j < 2; ++j)
#pragma unroll
              for (int i = 0; i < 16; ++i) ((LAS bf16*)(L + GS_ST + (32 * vt + crow(i, h)) * 272))[32 * (2 * tt + j) + l31] = f2bf(S[j][i]); }
    }
    __syncthreads();
}
#ifndef MK_MASK
#define MK_MASK 0xffff
#endif
#ifndef MK_PROBE
#define MK_PROBE 0
#endif
#define TIDS const int tid = tid_(), wave = __builtin_amdgcn_readfirstlane(tid >> 6), lane = tid & 63, gw = blk * 8 + wave, gtid = blk * 512 + tid; (void)gw; (void)gtid; (void)lane; (void)wave;

template <int layer>
DI void layer_body(const Args& args, const XcdBarrier& xbar, LAS unsigned char* L, int lo, int hi) {
    const int G = gridDim.x, blk = blockIdx.x;
    const int NGW = G * 8, gthreads = G * 512;
    unsigned char* ws = args.ws;
    float* rope = (float*)(ws + WS_ROPE); float* G16 = (float*)(ws + WS_G16); bf16* halo = (bf16*)(ws + WS_HALO);
    bf16* memb = (bf16*)(ws + WS_MEMB); bf16* KVm = (bf16*)(ws + WS_KVM); bf16* hb = (bf16*)(ws + WS_HB); bf16* big = (bf16*)(ws + WS_BIG); bf16* act = (bf16*)(ws + WS_ACT);
    float* out = args.out;
    constexpr int P = 16 * layer, cb = layer ? 29 : 10;
    float* lnstats = (float*)(ws + WS_BAR + 256 * 1024);
#define IN(k) (lo <= (k) && (k) < hi)
#define SEAM(k) do { if (IN(k) && IN((k) + 1)) xcd_barrier(xbar); } while (0)
        if (IN(P + 1)) {
            { TIDS for (int task = blk * 2 + wave; wave < 2 && task < T / 32; task += 2 * G) gate_cols(hb, (const bf16*)(ws + WS_WIN) + (size_t)(layer ? 4096 : 3072) * 1024, G16, task); }
            { const int N = layer ? 4096 : 3072;
              pg8::Gemm g{hb, (const bf16*)(ws + WS_WIN), T, N, 1024, 1024}; pg8::StaticOrder S; S.init(T, N, G, blk);
              pg8::EpiBf16 E{big, layer ? 4096 : 3072, layer ? 16 : 12, G16, layer ? halo : nullptr};
              if (MK_MASK & 128) pg8::gemm_phase<pg8::EpiBf16, pg8::StaticOrder, true, true>(L, g, S, E); }
            if (layer == 0 || G < 128) { pg8::Gemm g{memb, (const bf16*)(ws + WS_WKV), TM, 2048, 1024, 1024}; pg8::StaticOrder S; S.init(TM, 2048, G, blk);
              pg8::EpiBf16 E{KVm, 2048, 1 << 30, nullptr, nullptr};
              if (MK_MASK & 128) pg8::gemm_phase<pg8::EpiBf16, pg8::StaticOrder, true, true>(L, g, S, E); }
        }
        SEAM(P + 1);
        if (layer == 0) {
            if (IN(2)) {
                float* LOC = (float*)(ws + 184 * MiB); bf16* SST = (bf16*)(ws + 216 * MiB); float* DEC = (float*)(ws + 232 * MiB);
                for (int u = blk; u < 1024; u += G) gla_passA_unit(big, G16, inptr(6), inptr(7), LOC, DEC, L, u >> 7, (u >> 5) & 3, u & 31);
                { float lam; { TIDS const float* lf = inptr(4); const float a = wave_sum(lf[lane] * lf[64 + lane]), c = wave_sum(lf[128 + lane] * lf[192 + lane]); lam = __expf(a) - __expf(c) + 0.2f; }
                  for (int p = 0;; ++p) { const int u = (p & 1) ? (p + 1) * G - 1 - blk : p * G + blk; if (u >= 512 || p * G >= 512) break;
                      const int qb = 15 - (u >> 5), bh = u & 31; diffattn_unit(big, rope, inptr(5), hb, L, bh >> 2, bh & 3, qb, lam); } }
                xcd_barrier(xbar);
                for (int u = blk; u < 256; u += G) gla_passB(LOC, DEC, SST, u >> 3, u & 7);
                xcd_barrier(xbar);
                for (int u = blk; u < 1024; u += G) gla_passC_unit(big, G16, inptr(6), inptr(7), inptr(8), SST, hb, L, u >> 7, (u >> 5) & 3, u & 31);
            }
            SEAM(2);
        } else {
            unsigned* gflags = (unsigned*)(ws + WS_BAR) + 16384;
            const bool piped = (G >= 128);
            if (IN(P + 2)) {
                if (!piped) { for (int u = blk; u < 2048; u += G) gdn_prep_unit(big, G16, halo, inptr(24), inptr(25), inptr(26), hb, L, u >> 8, (u >> 3) & 31, u & 7, false, nullptr); }
                else if (blk >= 64) { for (int v = blk - 64; v < 2048; v += G - 64) { const int n = v >> 6, bh = v & 63; gdn_prep_unit(big, G16, halo, inptr(24), inptr(25), inptr(26), hb, L, bh >> 3, n, bh & 7, false, gflags + bh * 32 + n); } }
                else {
                    if (G != 256) { pg8::Gemm g{memb, (const bf16*)(ws + WS_WKV), TM, 2048, 1024, 1024}; pg8::StaticOrder S; S.init(TM, 2048, 64, blk);
                      pg8::EpiBf16 E{KVm, 2048, 1 << 30, nullptr, nullptr};
                      pg8::gemm_phase<pg8::EpiBf16, pg8::StaticOrder, true, true>(L, g, S, E); }
                    gdn_scan_unit(big, G16, hb, inptr(27), L, blk >> 3, blk & 7, false, gflags);
                }
            }
            SEAM(P + 2);
        }
        if (layer == 1 && G < 128) {
            if (IN(P + 3)) for (int u = blk; u < 64; u += G) gdn_scan_unit(big, G16, hb, inptr(27), L, u >> 3, u & 7, false, nullptr);
            SEAM(P + 3);
        }
        { const int ph = layer ? P + 4 : 3;
          if (IN(ph)) { pg8::Gemm g{layer ? big + 3072 : hb, (const bf16*)(ws + WS_WOUT), T, 1024, 1024, layer ? 4096 : 1024}; pg8::StaticOrder S; S.init(T, 1024, G, blk);
              pg8::EpiRes<layer == 1> E{layer ? out : inptr(0), out, lnstats, inptr(10 + 11), inptr(10 + 12), ALPHA, 0};
              pg8::gemm_phase<pg8::EpiRes<layer == 1>, pg8::StaticOrder, true, true>(L, g, S, E); }
          SEAM(ph); }
        const int Q0 = layer ? P + 5 : 4;
        if (IN(Q0)) { TIDS ln_apply(out, inptr(cb + 0), inptr(cb + 1), out, hb, lnstats, gw, NGW, lane); }
        SEAM(Q0);
        const bool qfuse = (G == 256);
        bf16* oxa = qfuse ? act : hb;
        if (IN(Q0 + 1)) { pg8::Gemm g{hb, (const bf16*)(ws + WS_WQ), T, 1024, 1024, 1024}; pg8::StaticOrder S; S.init(T, 1024, G, blk);
            pg8::EpiBf16 E{big, 1024, 1 << 30, nullptr, nullptr};
            pg8::gemm_phase<pg8::EpiBf16, pg8::StaticOrder, true, true>(L, g, S, E);
            if (qfuse) { int qpm, qpn; if (so_next(S, 0, qpm, qpn)) { asm volatile("s_waitcnt vmcnt(0)" ::: "memory"); __syncthreads(); xattn_unit(big, KVm, oxa, L, qpm >> 3, qpn, qpm & 7); } } }
        if (!qfuse) { SEAM(Q0 + 1);
            if (IN(Q0 + 2)) for (int u = blk; u < 256; u += G) xattn_unit(big, KVm, oxa, L, u >> 5, (u >> 3) & 3, u & 7); }
        SEAM(Q0 + 2);
        if (IN(Q0 + 3)) { pg8::Gemm g{oxa, (const bf16*)(ws + WS_WO), T, 1024, 1024, 1024}; pg8::StaticOrder S; S.init(T, 1024, G, blk);
            pg8::EpiRes<true> E{out, out, lnstats, inptr(cb + 0), inptr(cb + 1), ALPHA, 0};
            pg8::gemm_phase<pg8::EpiRes<true>, pg8::StaticOrder, true, true>(L, g, S, E); }
        SEAM(Q0 + 3);
        if (IN(Q0 + 4)) { TIDS ln_apply(out, inptr(cb + 5), inptr(cb + 6), out, hb, lnstats, gw, NGW, lane); }
        SEAM(Q0 + 4);
        if (IN(Q0 + 5)) { pg8::Gemm g{hb, (const bf16*)(ws + WS_WFI), T, 2 * DFF, 1024, 1024}; pg8::StaticOrder S; S.init(T, 2 * DFF, G, blk);
            pg8::EpiFfn E{big, inptr(cb + 8), inptr(cb + 9), (float*)(ws + WS_ACT), L + 131072};
            pg8::gemm_phase<pg8::EpiFfn, pg8::StaticOrder, true, true>(L, g, S, E);
            if (layer == 0 && G == 256 && blk >= 128 && blk < 192) {
                pg8::Gemm g2{memb, (const bf16*)(ws + WS_WKV1), TM, 2048, 1024, 1024}; pg8::StaticOrder S2; S2.init(TM, 2048, 64, blk - 128);
                pg8::EpiBf16 E2{KVm, 2048, 1 << 30, nullptr, nullptr};
                pg8::gemm_phase<pg8::EpiBf16, pg8::StaticOrder, true, true>(L, g2, S2, E2); } }
        SEAM(Q0 + 5);
        if (IN(Q0 + 5) && IN(Q0 + 7)) { pg8::Gemm g{big, (const bf16*)(ws + WS_WFOA), T, 1024, DFF, DFF}; pg8::StaticOrder S; S.init(T, 1024, G, blk);
            { TIDS int fpm, fpn; for (int i = 0; so_next(S, i, fpm, fpn); ++i) ffn_fix((const float*)(ws + WS_ACT), big, inptr(cb + 8), inptr(cb + 9), fpm, tid);
              asm volatile("s_waitcnt vmcnt(0)" ::: "memory"); __syncthreads(); }
            pg8::EpiRes<true> E{out, out, lnstats, inptr(cb + 5), inptr(cb + 6), ALPHA, 0};
            pg8::gemm_phase<pg8::EpiRes<true>, pg8::StaticOrder, true, true>(L, g, S, E); }
        SEAM(Q0 + 7);
        const int LN3 = Q0 + 8;
        if (IN(LN3)) { TIDS ln_apply(out, inptr(cb + 11), inptr(cb + 12), out, layer ? nullptr : hb, layer ? nullptr : lnstats, gw, NGW, lane);
            if (layer == 0) { if (MK_MASK & 1) convert_weights(args, 1, L, gw, NGW, wave, lane); } }
        if (layer == 0) SEAM(LN3);

#undef IN
#undef SEAM
}
#ifndef MK_CG_SEAM0
#define MK_CG_SEAM0 0
#endif
#ifndef MK_PER_PHASE
#define MK_PER_PHASE 0
#endif
#ifndef MK_MASK
#define MK_MASK 0xffff
#endif
#ifndef MK_PROBE
#define MK_PROBE 0
#endif
constexpr int NPHASE = 33;
__global__ void __launch_bounds__(512, 2) mk_fwd(Args args) {
    extern __shared__ __attribute__((aligned(16))) unsigned char lds_raw[];
    LAS unsigned char* L = (LAS unsigned char*)lds_raw;
    const int G = gridDim.x, blk = blockIdx.x;
    const int NGW = G * 8, gthreads = G * 512;
    unsigned char* ws = args.ws;
    float* rope = (float*)(ws + WS_ROPE); float* G16 = (float*)(ws + WS_G16); bf16* halo = (bf16*)(ws + WS_HALO);
    bf16* memb = (bf16*)(ws + WS_MEMB); bf16* KVm = (bf16*)(ws + WS_KVM); bf16* hb = (bf16*)(ws + WS_HB); bf16* big = (bf16*)(ws + WS_BIG); bf16* act = (bf16*)(ws + WS_ACT);
    const int lo = args.ph_lo, hi = args.ph_hi;
    volatile LAS unsigned* xst = (volatile LAS unsigned*)(L + LDS_BYTES - 16);
    if (threadIdx.x < 4) xst[threadIdx.x] = 0u;
    __syncthreads();
    const XcdBarrier xbar = xcd_barrier_post((unsigned*)(ws + WS_BAR), xst);
#define IN(k) (lo <= (k) && (k) < hi)
#define SEAM(k) do { if (IN(k) && IN((k) + 1)) xcd_barrier(xbar); } while (0)
    float* out = args.out;
    if (IN(0)) { TIDS
        if (MK_MASK & 1) convert_weights(args, 0, L, gw, NGW, wave, lane);
        to_bf16(inptr(0), hb, (size_t)T * D, gtid, gthreads);
        to_bf16(inptr(1), memb, (size_t)TM * D, gtid, gthreads);
        { LAS float* scr = (LAS float*)(L + wave * 16384); const float* wkv1 = inptr(29 + 3);
          for (int r = gw; r < 16 * 64; r += NGW) { const int kb = r / 64, n0 = 32 * (r % 64); transpose_item(wkv1, 2048, (bf16*)(ws + WS_WKV1), 1024, 64 * kb, n0, n0, 64 * kb, scr, lane); } }
        rope_table((const int*)inptr(2), rope, gtid, gthreads);
    }
#if MK_CG_SEAM0
    if (IN(0) && IN(1)) cg::this_grid().sync();
#else
    SEAM(0);
#endif
    layer_body<0>(args, xbar, L, lo, hi);
    layer_body<1>(args, xbar, L, lo, hi);
#undef IN
#undef SEAM
}

extern "C" void kernel_launch(void* const* d_in, const int* in_sizes, int n_in, void* d_out, int out_size, void* d_ws, size_t ws_size, hipStream_t stream) {
    static int grid = 0;
    if (grid == 0) {
        int dev = 0, cus = 0, per_cu = 0;
        hipGetDevice(&dev); hipDeviceGetAttribute(&cus, hipDeviceAttributeMultiprocessorCount, dev);
        hipFuncSetAttribute((const void*)mk_fwd, hipFuncAttributeMaxDynamicSharedMemorySize, LDS_BYTES);
        if (hipOccupancyMaxActiveBlocksPerMultiprocessor(&per_cu, (const void*)mk_fwd, 512, LDS_BYTES) != hipSuccess || per_cu < 1) { per_cu = 1; (void)hipGetLastError(); }
        grid = cus * per_cu; if (grid > 256) grid = 256;
        if (n_in != 42 || ws_size < 256 * MiB) fprintf(stderr, "kernel_launch: unexpected n_in %d / ws %zu\n", n_in, ws_size);
    }
    Args a{};
    for (int i = 0; i < 42; ++i) a.in[i] = (const float*)d_in[i];
    a.out = (float*)d_out; a.ws = (unsigned char*)d_ws;
    (void)hipMemsetAsync((unsigned char*)d_ws + WS_BAR, 0, 16384 * 4 + 2048 * 4, stream);
#if MK_PER_PHASE
    for (int p = 0; p < NPHASE; ++p) { a.ph_lo = p; a.ph_hi = p + 1; hipLaunchKernelGGL(mk_fwd, dim3(grid), dim3(512), LDS_BYTES, stream, a); }
#else
    a.ph_lo = 0; a.ph_hi = NPHASE;
    void* kargs[] = {&a};
    hipError_t e = hipLaunchCooperativeKernel((const void*)mk_fwd, dim3(grid), dim3(512), kargs, LDS_BYTES, stream);
    if (e != hipSuccess) fprintf(stderr, "cooperative launch failed: %s (grid %d)\n", hipGetErrorString(e), grid);
#endif
}
```

```cpp
#include <hip/hip_runtime.h>
#include <hip/hip_cooperative_groups.h>
#include <cstdio>
#include <cstdint>
namespace cg = cooperative_groups;
__device__ __forceinline__ int tid_() { int t = threadIdx.x; asm volatile("" : "+v"(t)); return t; }
namespace pg8 {
#define PG8_LAS __attribute__((address_space(3)))
typedef unsigned short bf16_t;
typedef short bf16x8 __attribute__((ext_vector_type(8)));
typedef float f32x4 __attribute__((ext_vector_type(4)));
typedef unsigned u32x4 __attribute__((ext_vector_type(4)));
typedef unsigned u32x2 __attribute__((ext_vector_type(2)));
constexpr int BM = 256, BK = 64, HALF = 128, HTB = HALF * BK * 2  , STAGE_BYTES = 8 * HTB, NXCD = 8, WGM = 8;

__host__ __device__ __forceinline__ int lds_byte(int r, int c) { const int st = (r >> 4) * 2 + (c >> 5), rr = r & 15, cc = c & 31, ob = rr * 64 + cc * 2; return st * 1024 + (ob ^ (((ob >> 9) & 1) << 5)); }
__host__ __device__ __forceinline__ void stage_rc(int b, int& R, int& C) { const int st = b / 1024, sb = b % 1024, swz = sb ^ (((sb >> 9) & 1) << 5); R = (st >> 1) * 16 + swz / 64; C = (st & 1) * 32 + (swz % 64) / 2; }
__host__ __device__ __forceinline__ int perm32(int rho) { const int n = rho >> 4, i = rho & 15; return 8 * (i >> 2) + 4 * n + (i & 3); }

struct Unit { int pm, pn; };
struct Gemm { const bf16_t* A; const bf16_t* Bt; int M, N, K, lda; };

struct StaticOrder {
    int nM, nN, nwg, G, c;
    __host__ __device__ void init(int M, int N, int G_, int c_) { nM = M / BM; nN = N / BM; nwg = nM * nN; G = G_; c = c_; }
    __host__ __device__ bool next(int i, Unit& u) const {
        const long L = (long)i * G + c; if (L >= nwg) return false;
        int wgid = (int)L; { const int q = nwg / NXCD, r = nwg % NXCD, xcd = wgid % NXCD, off = wgid / NXCD; wgid = (xcd < r ? xcd * (q + 1) : r * (q + 1) + (xcd - r) * q) + off; }
        const int nig = WGM * nN, gid = wgid / nig, fm = gid * WGM, gsz = (nM - fm) < WGM ? (nM - fm) : WGM;
        u.pm = fm + ((wgid % nig) % gsz); u.pn = (wgid % nig) / gsz; return true;
    }
    __device__ __forceinline__ void a_ready(const Unit&) const {}
    __device__ __forceinline__ void done(const Unit&) const {}
};
__device__ __forceinline__ unsigned cvt_pk_bf16(float lo, float hi) { typedef float f2 __attribute__((ext_vector_type(2))); typedef __bf16 b2 __attribute__((ext_vector_type(2))); f2 v = {lo, hi}; b2 b = __builtin_convertvector(v, b2); return __builtin_bit_cast(unsigned, b); }
struct EpiBf16 {
    static constexpr bool PERM = true, AFTER_DRAIN = false;
    bf16_t* O; int ldc; int gate_pn; float* G16; bf16_t* halo;
    __device__ __forceinline__ void operator()(const f32x4 (&acc)[2][2][4][2], const Unit& u, int wr, int wc, int fr, int fq) const {
        const int row0 = u.pm * BM + wr * 64 + fr;
        if (u.pn >= gate_pn) {
            if (wc == 0 && fq < 2) {
#pragma unroll
                for (int ai = 0; ai < 2; ++ai)
#pragma unroll
                    for (int m = 0; m < 4; ++m) { float* p = G16 + (size_t)(row0 + ai * HALF + m * 16) * 16 + 8 * fq;
                        *(f32x4*)p = acc[ai][0][m][0]; *(f32x4*)(p + 4) = acc[ai][0][m][1]; }
            }
            return;
        }
        const int col0 = u.pn * BM + wc * 32 + 8 * fq;
#pragma unroll
        for (int ai = 0; ai < 2; ++ai)
#pragma unroll
            for (int m = 0; m < 4; ++m) { const int row = row0 + ai * HALF + m * 16; bf16_t* rowp = O + (size_t)row * ldc + col0;
#pragma unroll
                for (int bj = 0; bj < 2; ++bj) { const f32x4 v0 = acc[ai][bj][m][0], v1 = acc[ai][bj][m][1];
                    u32x4 w; w.x = cvt_pk_bf16(v0[0], v0[1]); w.y = cvt_pk_bf16(v0[2], v0[3]); w.z = cvt_pk_bf16(v1[0], v1[1]); w.w = cvt_pk_bf16(v1[2], v1[3]);
                    *(u32x4*)(rowp + bj * HALF) = w;
                    if (halo != nullptr && m == 3 && fr >= 13 && (col0 + bj * HALF) < 3072) *(u32x4*)(halo + ((size_t)(row >> 6) * 3 + (fr - 13)) * 3072 + col0 + bj * HALF) = w; } }
    }
};

__device__ __forceinline__ float dpp_ror1(float v) { return __builtin_bit_cast(float, __builtin_amdgcn_update_dpp(0, __builtin_bit_cast(int, v), 0x121, 0xf, 0xf, false)); }
__device__ __forceinline__ float dpp_ror2(float v) { return __builtin_bit_cast(float, __builtin_amdgcn_update_dpp(0, __builtin_bit_cast(int, v), 0x122, 0xf, 0xf, false)); }
struct EpiFfn {
    static constexpr bool PERM = true, AFTER_DRAIN = false;
    bf16_t* Act; const float* cw; const float* cbias; float* RAW; PG8_LAS unsigned char* xch;
    __device__ __forceinline__ void operator()(const f32x4 (&acc)[2][2][4][2], const Unit& u, int wr, int wc, int fr, int fq) const {
        const int c8 = wc * 32 + 8 * fq;
        const int ch = u.pn * 128 + c8;
        if (fr >= 14) {
#pragma unroll
            for (int ai = 0; ai < 2; ++ai)
#pragma unroll
                for (int bj = 0; bj < 2; ++bj)
#pragma unroll
                    for (int n = 0; n < 2; ++n) *(PG8_LAS f32x4*)(xch + ((((ai * 2 + wr) * 2 + (fr - 14)) * 256) + bj * 128 + c8 + 4 * n) * 4) = acc[ai][bj][3][n];
        }
        asm volatile("s_waitcnt lgkmcnt(0)" ::: "memory"); __builtin_amdgcn_s_barrier(); asm volatile("" ::: "memory");
        if (wr == 0 && fr < 2) {
#pragma unroll
            for (int n = 0; n < 2; ++n) { float* p = RAW + ((size_t)u.pm * 4 + fr) * 5632 + ch + 4 * n; *(f32x4*)p = acc[0][0][0][n]; *(f32x4*)(p + 2816) = acc[0][1][0][n]; } }
        if (wr == 1 && fr >= 14) {
#pragma unroll
            for (int n = 0; n < 2; ++n) { float* p = RAW + ((size_t)u.pm * 4 + 2 + (fr - 14)) * 5632 + ch + 4 * n; *(f32x4*)p = acc[1][0][3][n]; *(f32x4*)(p + 2816) = acc[1][1][3][n]; } }
#pragma unroll
        for (int n = 0; n < 2; ++n) {
            asm volatile("" ::: "memory");
            f32x4 wv[2][4];
#pragma unroll
            for (int bj = 0; bj < 2; ++bj) {
#pragma unroll
                for (int j = 0; j < 3; ++j) wv[bj][j] = *(const f32x4*)(cw + (size_t)j * 5632 + bj * 2816 + ch + 4 * n);
                wv[bj][3] = *(const f32x4*)(cbias + bj * 2816 + ch + 4 * n); }
#pragma unroll
            for (int ai = 0; ai < 2; ++ai) {
                const int prev = (wr == 1) ? (ai * 2 + 0) : (ai == 1 ? 1 : -1);
                f32x4 vm1[2];
#pragma unroll
                for (int bj = 0; bj < 2; ++bj) { f32x4 z = {0.f, 0.f, 0.f, 0.f};
                    if (prev >= 0 && fr >= 14) z = *(PG8_LAS const f32x4*)(xch + (((prev * 2 + (fr - 14)) * 256) + bj * 128 + c8 + 4 * n) * 4);
                    vm1[bj] = z; }
#pragma unroll
                for (int m = 0; m < 4; ++m) {
                    f32x4 cv[2];
#pragma unroll
                    for (int bj = 0; bj < 2; ++bj) { const f32x4 x = acc[ai][bj][m][n]; const f32x4 xm = (m == 0) ? vm1[bj] : acc[ai][bj][m == 0 ? 0 : m - 1][n];
                        f32x4 r;
#pragma unroll
                        for (int e = 0; e < 4; ++e) { const float a1 = dpp_ror1(x[e]), b1 = dpp_ror1(xm[e]), a2 = dpp_ror2(x[e]), b2 = dpp_ror2(xm[e]);
                            const float p1 = (fr == 0) ? b1 : a1, p2 = (fr < 2) ? b2 : a2;
                            r[e] = wv[bj][3][e] + wv[bj][2][e] * x[e] + wv[bj][1][e] * p1 + wv[bj][0][e] * p2; }
                        cv[bj] = r; }
                    float o[4];
#pragma unroll
                    for (int e = 0; e < 4; ++e) { const float g = cv[0][e]; o[e] = g * __builtin_amdgcn_rcpf(1.f + __expf(-g)) * cv[1][e]; }
                    u32x2 w; w.x = cvt_pk_bf16(o[0], o[1]); w.y = cvt_pk_bf16(o[2], o[3]);
                    const int row = u.pm * BM + ai * HALF + wr * 64 + m * 16 + fr;
                    *(u32x2*)(Act + (size_t)row * 2816 + ch + 4 * n) = w;
                }
            }
        }
    }
};
template <bool LN> struct EpiRes {
    static constexpr bool PERM = false, AFTER_DRAIN = false;
    const float* resid; float* out; const float* stats; const float* g; const float* bta; float alpha; int pad_;
    __device__ __forceinline__ void operator()(const f32x4 (&acc)[2][2][4][2], const Unit& u, int wr, int wc, int fr, int fq) const {
        typedef float f32x2v __attribute__((ext_vector_type(2)));
        const int row0 = u.pm * BM + wr * 64 + fr, col0 = u.pn * BM + wc * 32 + 4 * fq;
#pragma unroll
        for (int bj = 0; bj < 2; ++bj)
#pragma unroll
            for (int n = 0; n < 2; ++n) {
                f32x4 gv, bv;
                if constexpr (LN) { gv = *(const f32x4*)(g + col0 + bj * HALF + n * 16) * alpha; bv = *(const f32x4*)(bta + col0 + bj * HALF + n * 16) * alpha; }
                else { gv = (f32x4){alpha, alpha, alpha, alpha}; bv = (f32x4){0.f, 0.f, 0.f, 0.f}; }
#pragma unroll
                for (int ai = 0; ai < 2; ++ai)
#pragma unroll
                    for (int m = 0; m < 4; ++m) { const int row = row0 + ai * HALF + m * 16; const size_t o = (size_t)row * 1024 + col0 + bj * HALF + n * 16;
                        f32x4 r = *(const f32x4*)(resid + o);
                        if constexpr (LN) { const f32x2v sr = *(const f32x2v*)(stats + 2 * row); r = (r - sr.x) * sr.y; }
                        *(f32x4*)(out + o) = r * gv + bv + acc[ai][bj][m][n]; } }
    }
};
template <class Epi, class Sched, bool ALIGN_EPI = false, bool SP2 = false>
__device__ __forceinline__ void gemm_phase(PG8_LAS unsigned char* lds, const Gemm g, const Sched& S, const Epi& E) {
    const int tid = tid_(), wid = __builtin_amdgcn_readfirstlane(tid >> 6), lane = tid & 63, wr = wid >> 2, wc = wid & 3, fr = lane & 15, fq = lane >> 4;
    const int K = g.K, nt = K / BK;
    unsigned voffA[2], voffB[2];
#pragma unroll
    for (int i = 0; i < 2; ++i) { int R, C; stage_rc(tid * 16 + i * 8192, R, C); const int Rb = Epi::PERM ? ((R & ~31) + perm32(R & 31)) : R;
        voffA[i] = (unsigned)(R * g.lda + C) * 2u; voffB[i] = (unsigned)(Rb * K + C) * 2u; }
    const size_t kstep = (size_t)(BK * 2);
    const size_t hstepA = (size_t)HALF * g.lda * 2, hstepB = (size_t)HALF * K * 2;
    const size_t tstepA = 2 * hstepA, tstepB = 2 * hstepB;
    const unsigned ldsw = (unsigned)wid * 1024u;
    const int aoff = lds_byte(wr * 64 + fr, fq * 8), boff = lds_byte(wc * 32 + fr, fq * 8);
#define PG8_SA(b, h) (((b) * 2 + (h)) * HTB)
#define PG8_SB(b, h) ((4 + (b) * 2 + (h)) * HTB)
#define PG8_STAGE(bufoff, gbase, voff) do { _Pragma("unroll") for (int _i = 0; _i < 2; ++_i) \
        __builtin_amdgcn_global_load_lds((const unsigned*)((const char*)(gbase) + (voff)[_i]), (PG8_LAS unsigned*)(lds + (bufoff) + ldsw + _i * 8192), 16, 0, 0); } while (0)
#define PG8_LDA(dst, b, h) do { _Pragma("unroll") for (int m = 0; m < 4; ++m) _Pragma("unroll") for (int k = 0; k < 2; ++k) dst[m][k] = *(const PG8_LAS bf16x8*)(lds + PG8_SA(b, h) + aoff + m * 2048 + k * 1024); } while (0)
#define PG8_LDB(dst, b, h) do { _Pragma("unroll") for (int n = 0; n < 2; ++n) _Pragma("unroll") for (int k = 0; k < 2; ++k) dst[n][k] = *(const PG8_LAS bf16x8*)(lds + PG8_SB(b, h) + boff + n * 2048 + k * 1024); } while (0)
#define PG8_MMA(ai, bj, At, Bt) do { __builtin_amdgcn_s_setprio(1); _Pragma("unroll") for (int m = 0; m < 4; ++m) _Pragma("unroll") for (int n = 0; n < 2; ++n) _Pragma("unroll") for (int k = 0; k < 2; ++k) \
        acc[ai][bj][m][n] = __builtin_amdgcn_mfma_f32_16x16x32_bf16(Bt[n][k], At[m][k], acc[ai][bj][m][n], 0, 0, 0); __builtin_amdgcn_s_setprio(0); } while (0)
#define PG8_WAIT_V(n) asm volatile("s_waitcnt vmcnt(" #n ")" ::: "memory")
#define PG8_WAIT_L(n) asm volatile("s_waitcnt lgkmcnt(" #n ")" ::: "memory")
#define PG8_BAR __builtin_amdgcn_s_barrier()
#define PG8_SCHED __builtin_amdgcn_sched_barrier(0)
    Unit cur, nxt; int ui = 0;
    if (!S.next(0, cur)) return;
    f32x4 acc[2][2][4][2];
#pragma unroll
    for (int a = 0; a < 2; ++a)
#pragma unroll
        for (int b = 0; b < 2; ++b)
#pragma unroll
            for (int m = 0; m < 4; ++m)
#pragma unroll
                for (int n = 0; n < 2; ++n) acc[a][b][m][n] = (f32x4){0.f, 0.f, 0.f, 0.f};
    bf16x8 At[4][2], B0[2][2], B1[2][2];
    const char* cA = (const char*)g.A + (size_t)cur.pm * tstepA; const char* cB = (const char*)g.Bt + (size_t)cur.pn * tstepB;
    S.a_ready(cur);
    if constexpr (SP2) {
        PG8_STAGE(PG8_SB(0, 0), cB, voffB); PG8_STAGE(PG8_SB(0, 1), cB + hstepB, voffB); PG8_STAGE(PG8_SA(0, 0), cA, voffA); PG8_STAGE(PG8_SA(0, 1), cA + hstepA, voffA);
        if (wr == 1) PG8_BAR;
        PG8_WAIT_V(2); PG8_BAR;
        PG8_STAGE(PG8_SB(1, 0), cB + kstep, voffB); PG8_STAGE(PG8_SA(1, 0), cA + kstep, voffA); PG8_STAGE(PG8_SB(1, 1), cB + hstepB + kstep, voffB);
        PG8_WAIT_V(6); PG8_BAR;
    } else {
        PG8_STAGE(PG8_SB(0, 0), cB, voffB); PG8_STAGE(PG8_SA(0, 0), cA, voffA); PG8_STAGE(PG8_SB(0, 1), cB + hstepB, voffB); PG8_STAGE(PG8_SA(0, 1), cA + hstepA, voffA);
        if (wr == 1) PG8_BAR;
        PG8_WAIT_V(4); PG8_BAR;
        PG8_STAGE(PG8_SB(1, 0), cB + kstep, voffB); PG8_STAGE(PG8_SA(1, 0), cA + kstep, voffA); PG8_STAGE(PG8_SB(1, 1), cB + hstepB + kstep, voffB);
        PG8_WAIT_V(6); PG8_BAR;
    }
    for (;;) {
        const bool has_next = S.next(ui + 1, nxt);
        const char* nA = has_next ? (const char*)g.A + (size_t)nxt.pm * tstepA : cA; const char* nB = has_next ? (const char*)g.Bt + (size_t)nxt.pn * tstepB : cB;
        for (int t = 0; t < nt; t += 2) {
            const bool last = (t == nt - 2);
            const char* a1 = cA + (size_t)(t + 1) * kstep;
            const char* a2 = last ? nA : cA + (size_t)(t + 2) * kstep; const char* b2 = last ? nB : cB + (size_t)(t + 2) * kstep;
            const char* a3 = a2 + kstep; const char* b3 = b2 + kstep;
            if (last && has_next) S.a_ready(nxt);
            if constexpr (SP2) {
            PG8_LDB(B0, 0, 0); PG8_LDB(B1, 0, 1); PG8_SCHED; PG8_LDA(At, 0, 0); PG8_STAGE(PG8_SA(1, 1), a1 + hstepA, voffA);
            PG8_WAIT_V(8); PG8_WAIT_L(0); PG8_BAR; PG8_MMA(0, 0, At, B0); PG8_MMA(0, 1, At, B1); PG8_BAR; PG8_SCHED;
            PG8_LDA(At, 0, 1); PG8_STAGE(PG8_SB(0, 0), b2, voffB); PG8_STAGE(PG8_SB(0, 1), b2 + hstepB, voffB); PG8_STAGE(PG8_SA(0, 0), a2, voffA);
            PG8_WAIT_V(8); PG8_WAIT_L(0); PG8_BAR; PG8_MMA(1, 0, At, B0); PG8_MMA(1, 1, At, B1); PG8_BAR; PG8_SCHED;
            PG8_LDB(B0, 1, 0); PG8_LDB(B1, 1, 1); PG8_SCHED; PG8_LDA(At, 1, 0); PG8_STAGE(PG8_SA(0, 1), a2 + hstepA, voffA);
            PG8_WAIT_V(8); PG8_WAIT_L(0); PG8_BAR; PG8_MMA(0, 0, At, B0); PG8_MMA(0, 1, At, B1); PG8_BAR; PG8_SCHED;
            PG8_LDA(At, 1, 1); PG8_STAGE(PG8_SB(1, 0), b3, voffB); PG8_STAGE(PG8_SB(1, 1), b3 + hstepB, voffB); PG8_STAGE(PG8_SA(1, 0), a3, voffA);
            PG8_WAIT_V(8); PG8_WAIT_L(0); PG8_BAR; PG8_MMA(1, 0, At, B0); PG8_MMA(1, 1, At, B1); PG8_BAR; PG8_SCHED;
            } else {
            PG8_LDB(B0, 0, 0); PG8_SCHED; PG8_LDA(At, 0, 0); PG8_STAGE(PG8_SA(1, 1), a1 + hstepA, voffA);
            PG8_WAIT_L(8); PG8_BAR; PG8_WAIT_L(0); PG8_MMA(0, 0, At, B0); PG8_BAR; PG8_SCHED;
            PG8_LDB(B1, 0, 1); PG8_STAGE(PG8_SB(0, 0), b2, voffB);
            PG8_BAR; PG8_WAIT_L(0); PG8_MMA(0, 1, At, B1); PG8_BAR;
            PG8_LDA(At, 0, 1); PG8_STAGE(PG8_SA(0, 0), a2, voffA);
            PG8_BAR; PG8_WAIT_L(0); PG8_MMA(1, 0, At, B0); PG8_BAR; PG8_SCHED;
            PG8_STAGE(PG8_SB(0, 1), b2 + hstepB, voffB);
            PG8_WAIT_V(6); PG8_BAR; PG8_MMA(1, 1, At, B1); PG8_BAR;
            PG8_LDB(B0, 1, 0); PG8_SCHED; PG8_LDA(At, 1, 0); PG8_STAGE(PG8_SA(0, 1), a2 + hstepA, voffA);
            PG8_WAIT_L(8); PG8_BAR; PG8_WAIT_L(0); PG8_MMA(0, 0, At, B0); PG8_BAR; PG8_SCHED;
            PG8_LDB(B1, 1, 1); PG8_STAGE(PG8_SB(1, 0), b3, voffB);
            PG8_BAR; PG8_WAIT_L(0); PG8_MMA(0, 1, At, B1); PG8_BAR;
            PG8_LDA(At, 1, 1); PG8_STAGE(PG8_SA(1, 0), a3, voffA);
            PG8_BAR; PG8_WAIT_L(0); PG8_MMA(1, 0, At, B0); PG8_BAR; PG8_SCHED;
            PG8_STAGE(PG8_SB(1, 1), b3 + hstepB, voffB);
            PG8_WAIT_V(6); PG8_BAR; PG8_MMA(1, 1, At, B1); PG8_BAR;
            }
        }
        if constexpr (ALIGN_EPI) { if (wr == 0) PG8_BAR; }
        if constexpr (!Epi::AFTER_DRAIN) { E(acc, cur, wr, wc, fr, fq); S.done(cur); }
        if (!has_next) break;
#pragma unroll
        for (int a = 0; a < 2; ++a)
#pragma unroll
            for (int b = 0; b < 2; ++b)
#pragma unroll
                for (int m = 0; m < 4; ++m)
#pragma unroll
                    for (int n = 0; n < 2; ++n) acc[a][b][m][n] = (f32x4){0.f, 0.f, 0.f, 0.f};
        cur = nxt; cA = nA; cB = nB; ++ui;
        if constexpr (ALIGN_EPI) { if (wr == 1) PG8_BAR; }
    }
    PG8_WAIT_V(0);
    if constexpr (!ALIGN_EPI) { if (wr == 0) PG8_BAR; }
    PG8_BAR;
    if constexpr (Epi::AFTER_DRAIN) { E.fused(acc, cur, wr, wc, fr, fq, lds, wid, lane); S.done(cur); }
#undef PG8_SA
#undef PG8_SB
#undef PG8_STAGE
#undef PG8_LDA
#undef PG8_LDB
#undef PG8_MMA
#undef PG8_WAIT_V
#undef PG8_WAIT_L
#undef PG8_BAR
#undef PG8_SCHED
}
}
#define LAS __attribute__((address_space(3)))
#define DI __device__ __forceinline__
typedef unsigned short bf16;
typedef short bf16x8 __attribute__((ext_vector_type(8)));
typedef short s16x4 __attribute__((ext_vector_type(4)));
typedef float f32x4 __attribute__((ext_vector_type(4)));
typedef float f32x16 __attribute__((ext_vector_type(16)));
typedef unsigned u32x4 __attribute__((ext_vector_type(4)));
typedef unsigned u32x2 __attribute__((ext_vector_type(2)));
#define LDS_WAIT() asm volatile("s_waitcnt lgkmcnt(0)" ::: "memory")
#define MFMA32(a, b, c) __builtin_amdgcn_mfma_f32_32x32x16_bf16((a), (b), (c), 0, 0, 0)
#define LBAR() do { asm volatile("s_waitcnt lgkmcnt(0)" ::: "memory"); __builtin_amdgcn_s_barrier(); asm volatile("" ::: "memory"); } while (0)

constexpr int T = 16384, D = 1024, SEQ = 2048, NB = 8, TM = 2048;
constexpr int DFF = 2816, DFH = 1408;
constexpr float ALPHA = 1.4142135623730951f;
constexpr float LOG2E = 1.4426950408889634f;
constexpr size_t MiB = 1u << 20;
constexpr size_t WS_ROPE = 0;
constexpr size_t WS_G16 = 1 * MiB;
constexpr size_t WS_HALO = 2 * MiB;
constexpr size_t WS_MEMB = 7 * MiB;
constexpr size_t WS_KVM = 11 * MiB;
constexpr size_t WS_WIN = 19 * MiB;
constexpr size_t WS_WOUT = 28 * MiB, WS_WQ = 30 * MiB, WS_WKV = 32 * MiB, WS_WO = 36 * MiB, WS_WFI = 38 * MiB, WS_WFOA = 49 * MiB, WS_WFOB = 52 * MiB;
constexpr size_t WS_HB = 56 * MiB;
constexpr size_t WS_BIG = 88 * MiB;
constexpr size_t WS_ACT = 176 * MiB;
constexpr size_t WS_WKV1 = 240 * MiB;
constexpr int LDS_BYTES = 147456;

DI unsigned cvtpk(float lo, float hi) { return pg8::cvt_pk_bf16(lo, hi); }
DI bf16 f2bf(float f) { return (bf16)(cvtpk(f, 0.f) & 0xffffu); }
DI float bf2f(bf16 v) { return __uint_as_float(((unsigned)v) << 16); }
DI float bflo(unsigned w) { return __uint_as_float(w << 16); }
DI float bfhi(unsigned w) { return __uint_as_float(w & 0xffff0000u); }
DI int crow(int i, int h) { return (i & 3) + 8 * (i >> 2) + 4 * h; }
DI float wave_sum(float v) {
#pragma unroll
    for (int o = 1; o < 64; o <<= 1) v += __shfl_xor(v, o);
    return v;
}
DI float siluf(float x) { return x * __builtin_amdgcn_rcpf(1.f + __expf(-x)); }
DI float sigmoidf_(float x) { return __builtin_amdgcn_rcpf(1.f + __expf(-x)); }
DI bf16x8 pack8(const f32x16& x, int s) { u32x4 p; p.x = cvtpk(x[8 * s], x[8 * s + 1]); p.y = cvtpk(x[8 * s + 2], x[8 * s + 3]); p.z = cvtpk(x[8 * s + 4], x[8 * s + 5]); p.w = cvtpk(x[8 * s + 6], x[8 * s + 7]); return __builtin_bit_cast(bf16x8, p); }
DI bf16x8 lds_rd16(LAS const unsigned char* p) { return *(LAS const bf16x8*)p; }
DI bf16x8 lds_rd8x2(LAS const unsigned char* p) { const s16x4 lo = *(LAS const s16x4*)p, hi = *(LAS const s16x4*)(p + 16); return __builtin_shufflevector(lo, hi, 0, 1, 2, 3, 4, 5, 6, 7); }
DI void unpack8(const u32x4 w, float* f) { f[0] = bflo(w.x); f[1] = bfhi(w.x); f[2] = bflo(w.y); f[3] = bfhi(w.y); f[4] = bflo(w.z); f[5] = bfhi(w.z); f[6] = bflo(w.w); f[7] = bfhi(w.w); }
DI u32x4 packf8(const float* f) { u32x4 w; w.x = cvtpk(f[0], f[1]); w.y = cvtpk(f[2], f[3]); w.z = cvtpk(f[4], f[5]); w.w = cvtpk(f[6], f[7]); return w; }
DI void st16_wt(void* p, u32x4 v) { asm volatile("global_store_dwordx4 %0, %1, off sc1\n\ts_nop 1" :: "v"(p), "v"(v) : "memory"); }
DI void zero16(f32x16& a) {
#pragma unroll
    for (int i = 0; i < 16; ++i) a[i] = 0.f;
}

#define XB_TMO      128
#define XB_XCNT(j)  (256  + 64 * (j))
#define XB_XSUB(j)  (1280 + 64 * (j))
#define XB_XGEN(j)  (2304 + 64 * (j))
#define XB_TOP      3328
#define XB_TOPGEN   3392
#define XCD_BAR_WORDS 3456
#define XB_SPIN_CAP (1u << 18)

__device__ __forceinline__ unsigned xb_ld(unsigned* p)              { return __hip_atomic_load(p, __ATOMIC_RELAXED, __HIP_MEMORY_SCOPE_AGENT); }
__device__ __forceinline__ unsigned xb_add(unsigned* p, unsigned v) { return __hip_atomic_fetch_add(p, v, __ATOMIC_RELAXED, __HIP_MEMORY_SCOPE_AGENT); }
__device__ __forceinline__ unsigned xb_xcc_id() { return (unsigned)__builtin_amdgcn_s_getreg((3 << 11) | 20) & 0xFu; }
#define XB_SPIN(cond, bar) do { unsigned _sp = 0; while (cond) { __builtin_amdgcn_s_sleep(1); \
    if ((++_sp & 255u) == 0u) { if (xb_ld(&(bar)[XB_TMO])) break; if (_sp > XB_SPIN_CAP) { atomicAdd(&(bar)[XB_TMO], 1u); break; } } } } while (0)

struct XcdBarrier {
    unsigned* bar; unsigned x;
    volatile LAS unsigned* st;
};

__device__ __forceinline__ XcdBarrier xcd_barrier_post(unsigned* bar, volatile LAS unsigned* st) {
    XcdBarrier b; b.bar = bar; b.x = xb_xcc_id(); b.st = st;
    if (threadIdx.x == 0) (void)xb_add(&bar[XB_XCNT(b.x)], 1u);
    return b;
}
__device__ __forceinline__ void xcd_barrier_complete(unsigned* bar, unsigned x, unsigned& nloc, unsigned& nx) {
    const unsigned G = gridDim.x * gridDim.y * gridDim.z;
    unsigned sum, cnt, mine, sp = 0u;
    for (;;) {
        sum = 0u; cnt = 0u; mine = 0u;
#pragma unroll
        for (unsigned j = 0; j < 16; ++j) { const unsigned c = xb_ld(&bar[XB_XCNT(j)]); sum += c; cnt += (c > 0u) ? 1u : 0u; mine = (j == x) ? c : mine; }
        if (sum == G) break;
        __builtin_amdgcn_s_sleep(1);
        if ((++sp & 255u) == 0u) { if (xb_ld(&bar[XB_TMO])) break; if (sp > XB_SPIN_CAP) { atomicAdd(&bar[XB_TMO], 1u); break; } }
    }
    nloc = mine > 0u ? mine : 1u; nx = cnt > 0u ? cnt : 1u;
}

__device__ __forceinline__ void xcd_barrier(const XcdBarrier& b) {
    asm volatile("s_waitcnt vmcnt(0)" ::: "memory");
    __syncthreads();
    if (threadIdx.x == 0) {
        unsigned* bar = b.bar;
        __builtin_amdgcn_s_waitcnt(0);
        unsigned nloc = b.st[0], nx = b.st[1];
        if (nloc == 0u) { xcd_barrier_complete(bar, b.x, nloc, nx); b.st[0] = nloc; b.st[1] = nx; }
        const unsigned old = xb_add(&bar[XB_XSUB(b.x)], 1u);
        const unsigned gen = old / nloc;
        if (old + 1u == (gen + 1u) * nloc) {
            __builtin_amdgcn_fence(__ATOMIC_RELEASE, "agent");
            asm volatile("s_waitcnt vmcnt(0)" ::: "memory");
            const unsigned og = xb_add(&bar[XB_TOP], 1u);
            const unsigned tg = og / nx;
            if (og + 1u == (tg + 1u) * nx) xb_add(&bar[XB_TOPGEN], 1u);
            else XB_SPIN(xb_ld(&bar[XB_TOPGEN]) == tg, bar);
            __builtin_amdgcn_fence(__ATOMIC_ACQUIRE, "agent");
            xb_add(&bar[XB_XGEN(b.x)], 1u);
            asm volatile("s_waitcnt vmcnt(0)" ::: "memory");
        } else {
            XB_SPIN(xb_ld(&bar[XB_XGEN(b.x)]) == gen, bar);
            __builtin_amdgcn_fence(__ATOMIC_ACQUIRE, "agent");
            asm volatile("s_waitcnt vmcnt(0)" ::: "memory");
        }
    }
    __syncthreads();
}
constexpr size_t WS_BAR = 55 * MiB;
struct Args { const float* in[42]; float* out; unsigned char* ws; int ph_lo, ph_hi; };
#if defined(__HIP_DEVICE_COMPILE__)
DI const float* inptr(int i) { const void* p = (const void*)__builtin_amdgcn_kernarg_segment_ptr(); asm volatile("" : "+s"(p)); return ((const float* const*)p)[i]; }
#else
DI const float* inptr(int) { return nullptr; }
#endif

DI void transpose_item(const float* W, int ldw, bf16* WT, int ldt, int k0, int n0, int drow0, int dk0, LAS float* scr, int lane) {
    float tv[32];
#pragma unroll
    for (int i = 0; i < 32; ++i) { const int kk = 2 * i + (lane >> 5); tv[i] = W[(size_t)(k0 + kk) * ldw + n0 + (lane & 31)]; }
#pragma unroll
    for (int i = 0; i < 32; ++i) { const int kk = 2 * i + (lane >> 5); scr[kk * 33 + (lane & 31)] = tv[i]; }
    LDS_WAIT();
    const int c = lane & 7;
#pragma unroll
    for (int j = 0; j < 4; ++j) { const int n = (lane >> 3) + 8 * j; const LAS float* s = scr + (8 * c) * 33 + n;
        u32x4 o; o.x = cvtpk(s[0 * 33], s[1 * 33]); o.y = cvtpk(s[2 * 33], s[3 * 33]); o.z = cvtpk(s[4 * 33], s[5 * 33]); o.w = cvtpk(s[6 * 33], s[7 * 33]);
        *(u32x4*)(WT + (size_t)(drow0 + n) * ldt + dk0 + 8 * c) = o; }
    LDS_WAIT();
}
DI void convert_weights(const Args& a, int layer, LAS unsigned char* lds, int gw, int NGW, int wave, int lane) {
    unsigned char* ws = a.ws;
    const int cb = layer ? 29 : 10;
    const float* w_in = inptr(layer ? 23 : 3); const int nin = layer ? 4112 : 3088, nmain = layer ? 4096 : 3072;
    const float* w_out = inptr(layer ? 28 : 9);
    const float *wq = inptr(cb + 2), *wkv = inptr(cb + 3), *wo = inptr(cb + 4), *fin = inptr(cb + 7), *fout = inptr(cb + 10);
    LAS float* scr = (LAS float*)(lds + wave * 16384);
    const int I_IN = 16 * (nmain / 32), I_SQ = 16 * 32, I_KV = 16 * 64, I_FI = 16 * 176, I_FO = 44 * 32;
    const int NITEMS = I_IN + 3 * I_SQ + I_KV + I_FI + I_FO;
    for (int it = gw; it < NITEMS; it += NGW) {
        int r = it;
        if (r < I_IN) { const int nb = nmain / 32, kb = r / nb, n0 = 32 * (r % nb); transpose_item(w_in, nin, (bf16*)(ws + WS_WIN), 1024, 64 * kb, n0, n0, 64 * kb, scr, lane); continue; } r -= I_IN;
        if (r < I_SQ) { const int kb = r / 32, n0 = 32 * (r % 32); transpose_item(w_out, 1024, (bf16*)(ws + WS_WOUT), 1024, 64 * kb, n0, n0, 64 * kb, scr, lane); continue; } r -= I_SQ;
        if (r < I_SQ) { const int kb = r / 32, n0 = 32 * (r % 32); transpose_item(wq, 1024, (bf16*)(ws + WS_WQ), 1024, 64 * kb, n0, n0, 64 * kb, scr, lane); continue; } r -= I_SQ;
        if (r < I_SQ) { const int kb = r / 32, n0 = 32 * (r % 32); transpose_item(wo, 1024, (bf16*)(ws + WS_WO), 1024, 64 * kb, n0, n0, 64 * kb, scr, lane); continue; } r -= I_SQ;
        if (r < I_KV) { const int kb = r / 64, n0 = 32 * (r % 64); transpose_item(wkv, 2048, (bf16*)(ws + WS_WKV), 1024, 64 * kb, n0, n0, 64 * kb, scr, lane); continue; } r -= I_KV;
        if (r < I_FI) { const int kb = r / 176, n0 = 32 * (r % 176); const int half = n0 / DFF, c = n0 % DFF; const int drow = (c / 128) * 256 + half * 128 + (c % 128);
            transpose_item(fin, 2 * DFF, (bf16*)(ws + WS_WFI), 1024, 64 * kb, n0, drow, 64 * kb, scr, lane); continue; } r -= I_FI;
        { const int kb = r / 32, n0 = 32 * (r % 32); const int k0 = 64 * kb;
          transpose_item(fout, 1024, (bf16*)(ws + WS_WFOA), DFF, k0, n0, n0, k0, scr, lane); }
    }
    bf16* wt = (bf16*)(ws + WS_WIN);
    for (int idx = gw * 64 + lane; idx < 16 * 1024; idx += NGW * 64) { const int j = idx & 15, k = idx >> 4; wt[(size_t)(nmain + j) * 1024 + k] = f2bf(w_in[(size_t)k * nin + nmain + j]); }
}
DI void to_bf16(const float* src, bf16* dst, size_t n, int gtid, int gthreads) {
    for (size_t i = (size_t)gtid * 8; i < n; i += (size_t)gthreads * 8) { const f32x4 a = *(const f32x4*)(src + i), b = *(const f32x4*)(src + i + 4);
        u32x4 o; o.x = cvtpk(a[0], a[1]); o.y = cvtpk(a[2], a[3]); o.z = cvtpk(b[0], b[1]); o.w = cvtpk(b[2], b[3]); *(u32x4*)(dst + i) = o; }
}
DI void rope_table(const int* pos, float* tab, int gtid, int gthreads) {
    for (int i = gtid; i < T * 8; i += gthreads) { const int t = i >> 3, f = i & 7;
        const float inv = exp2f(-(float)f * (18.931568569324174f / 8.f));
        const double ang = (double)((float)pos[t] * inv);
        double r = ang * 0.15915494309189535; r -= floor(r);
        const float rf = (float)r;
        tab[(size_t)t * 16 + f] = __builtin_amdgcn_cosf(rf); tab[(size_t)t * 16 + 8 + f] = __builtin_amdgcn_sinf(rf); }
}
DI void ln_apply(const float* y, const float* g, const float* bta, float* outf, bf16* outb, float* stats, int gw, int NGW, int lane) {
    f32x4 gv[4], bv[4];
#pragma unroll
    for (int j = 0; j < 4; ++j) { gv[j] = ((const f32x4*)g)[lane + 64 * j]; bv[j] = ((const f32x4*)bta)[lane + 64 * j]; }
    const bool xl = (NGW == 2048); const int blk_ = gw >> 3, wv_ = gw & 7;
    const int mbeg = xl ? (blk_ & 7) * 2048 + ((blk_ >> 3) * 8 + wv_) * 8 : 2 * gw, mend = xl ? mbeg + 8 : T, mstep = xl ? 2 : 2 * NGW;
    for (int m0 = mbeg; m0 < mend; m0 += mstep) {
        f32x4 v[2][4]; float s[2] = {0.f, 0.f};
#pragma unroll
        for (int r = 0; r < 2; ++r) { const f32x4* xr = (const f32x4*)(y + (size_t)(m0 + r) * D) + lane;
#pragma unroll
            for (int j = 0; j < 4; ++j) v[r][j] = xr[64 * j]; }
#pragma unroll
        for (int r = 0; r < 2; ++r) {
#pragma unroll
            for (int j = 0; j < 4; ++j) s[r] += (v[r][j][0] + v[r][j][1]) + (v[r][j][2] + v[r][j][3]);
            const float mean = wave_sum(s[r]) * (1.f / D); float s2 = 0.f;
#pragma unroll
            for (int j = 0; j < 4; ++j) { v[r][j] = v[r][j] - mean; s2 += (v[r][j][0] * v[r][j][0] + v[r][j][1] * v[r][j][1]) + (v[r][j][2] * v[r][j][2] + v[r][j][3] * v[r][j][3]); }
            const float rstd = 1.f / sqrtf(wave_sum(s2) * (1.f / D) + 1e-5f);
            const size_t m = m0 + r;
            if (stats && lane == 0) { stats[2 * m] = mean; stats[2 * m + 1] = rstd; }
#pragma unroll
            for (int j = 0; j < 4; ++j) { const f32x4 o = v[r][j] * rstd * gv[j] + bv[j];
                if (!stats) ((f32x4*)(outf + m * D))[lane + 64 * j] = o;
                if (outb) { u32x2 w; w.x = cvtpk(o[0], o[1]); w.y = cvtpk(o[2], o[3]); ((u32x2*)(outb + m * D))[lane + 64 * j] = w; } }
        }
    }
}
DI bool so_next(const pg8::StaticOrder& S, int i, int& pm, int& pn) {
    const long Lx = (long)i * S.G + S.c; if (Lx >= S.nwg) return false;
    int wgid = (int)Lx; { const int q = S.nwg / pg8::NXCD, r = S.nwg % pg8::NXCD, xcd = wgid % pg8::NXCD, off = wgid / pg8::NXCD; wgid = (xcd < r ? xcd * (q + 1) : r * (q + 1) + (xcd - r) * q) + off; }
    const int nig = pg8::WGM * S.nN, gid = wgid / nig, fm = gid * pg8::WGM, gsz = (S.nM - fm) < pg8::WGM ? (S.nM - fm) : pg8::WGM;
    pm = fm + ((wgid % nig) % gsz); pn = (wgid % nig) / gsz; return true;
}
DI void ffn_fix(const float* RAW, bf16* Act, const float* cw, const float* cbias, int pm, int tid) {
    if ((pm & 7) == 0) return;
    for (int rem = tid; rem < 1408; rem += 512) {
        const int j = rem / 704, ch = 4 * (rem % 704);
        const float* x0 = RAW + ((size_t)pm * 4 + j) * 5632;
        const float* x1 = j == 0 ? RAW + ((size_t)(pm - 1) * 4 + 3) * 5632 : RAW + ((size_t)pm * 4 + 0) * 5632;
        const float* x2 = j == 0 ? RAW + ((size_t)(pm - 1) * 4 + 2) * 5632 : RAW + ((size_t)(pm - 1) * 4 + 3) * 5632;
        f32x4 cv[2];
#pragma unroll
        for (int bj = 0; bj < 2; ++bj) { const int col = bj * 2816 + ch;
            cv[bj] = *(const f32x4*)(cbias + col) + *(const f32x4*)(cw + 2 * 5632 + col) * *(const f32x4*)(x0 + col) + *(const f32x4*)(cw + 5632 + col) * *(const f32x4*)(x1 + col) + *(const f32x4*)(cw + col) * *(const f32x4*)(x2 + col); }
        u32x2 w; w.x = cvtpk(siluf(cv[0][0]) * cv[1][0], siluf(cv[0][1]) * cv[1][1]); w.y = cvtpk(siluf(cv[0][2]) * cv[1][2], siluf(cv[0][3]) * cv[1][3]);
        *(u32x2*)(Act + (size_t)(pm * 256 + j) * 2816 + ch) = w;
    }
}
DI void gate_cols(const bf16* A, const bf16* Wg, float* G16, int task) {
    const int lane = tid_() & 63, l31 = lane & 31, h = lane >> 5;
    const bf16* ap = A + (size_t)(32 * task + l31) * 1024 + 8 * h; const bf16* bp = Wg + (size_t)(l31 & 15) * 1024 + 8 * h;
    f32x16 c; zero16(c);
#pragma unroll 16
    for (int ks = 0; ks < 64; ++ks) { const bf16x8 a = *(const bf16x8*)(ap + 16 * ks); bf16x8 bb = *(const bf16x8*)(bp + 16 * ks);
        if (l31 >= 16) bb = (bf16x8){0, 0, 0, 0, 0, 0, 0, 0};
        c = MFMA32(a, bb, c); }
    if (l31 < 16) {
#pragma unroll
        for (int i = 0; i < 16; ++i) G16[(size_t)(32 * task + crow(i, h)) * 16 + l31] = c[i]; }
}
constexpr int DA_KS = 272, DA_VT = 144;
constexpr int DA_OFF_K = 0, DA_OFF_V = 64 * DA_KS, DA_OFF_C = DA_OFF_V + 128 * DA_VT;
DI void diffattn_unit(const bf16* Hin, const float* rope, const float* gnorm, bf16* Omix, LAS unsigned char* L, int b, int hh, int qb, float lam) {
    const int tid = tid_(), wave = __builtin_amdgcn_readfirstlane(tid >> 6), lane = tid & 63, l31 = lane & 31, h = lane >> 5;
    const int map = wave >> 2, wq = wave & 3;
    const int q0 = qb * 128 + wq * 32;
    const size_t tq = (size_t)b * SEQ + q0 + l31;
    bf16x8 qf[4];
    { const bf16* qrow = Hin + tq * 3072 + hh * 128 + map * 64;
#pragma unroll
      for (int ks = 1; ks < 4; ++ks) qf[ks] = *(const bf16x8*)(qrow + 16 * ks + 8 * h);
      float x1[8], x2[8], o[8]; unpack8(*(const u32x4*)qrow, x1); unpack8(*(const u32x4*)(qrow + 8), x2);
      const float* rt = rope + tq * 16;
#pragma unroll
      for (int j = 0; j < 8; ++j) { const float c = rt[j], s = rt[8 + j]; o[j] = h == 0 ? x1[j] * c - x2[j] * s : x2[j] * c + x1[j] * s; }
      qf[0] = __builtin_bit_cast(bf16x8, packf8(o)); }
    f32x16 o[4];
#pragma unroll
    for (int i = 0; i < 4; ++i) zero16(o[i]);
    float mrun = -INFINITY, lrun = 0.f;
    const float sc = 0.125f * LOG2E;
    const int kend = qb * 128 + 128;
    u32x4 pk[2], pp[2], pv[2]; f32x4 prc[2][2], prs[2][2];
#define DA_LOAD(kk) do { _Pragma("unroll") for (int i = 0; i < 2; ++i) { const int c = tid + 512 * i, key = c & 63, ch = c >> 6; const size_t tk = (size_t)b * SEQ + (kk) + key; \
        const bf16* krow = Hin + tk * 3072 + 512 + hh * 128; pk[i] = *(const u32x4*)(krow + 8 * ch); \
        if ((ch & 7) < 2) { pp[i] = *(const u32x4*)(krow + 8 * (ch ^ 1)); const f32x4* rt = (const f32x4*)(rope + tk * 16); prc[i][0] = rt[0]; prc[i][1] = rt[1]; prs[i][0] = rt[2]; prs[i][1] = rt[3]; } \
        pv[i] = *(const u32x4*)(Hin + tk * 3072 + 1024 + hh * 128 + 8 * ch); } } while (0)
    DA_LOAD(0);
    for (int k0 = 0; k0 < kend; k0 += 64) {
        LBAR();
#pragma unroll
        for (int i = 0; i < 2; ++i) { const int c = tid + 512 * i, key = c & 63, ch = c >> 6;
            u32x4 v = pk[i];
            if ((ch & 7) < 2) { float a[8], p[8], r[8]; unpack8(v, a); unpack8(pp[i], p);
#pragma unroll
                for (int j = 0; j < 8; ++j) { const float cc = prc[i][j >> 2][j & 3], sn = prs[i][j >> 2][j & 3]; r[j] = (ch & 1) == 0 ? a[j] * cc - p[j] * sn : a[j] * cc + p[j] * sn; }
                v = packf8(r); }
            *(LAS u32x4*)(L + DA_OFF_K + key * DA_KS + ch * 16) = v;
            const u32x4 vv = pv[i];
            LAS bf16* vt = (LAS bf16*)(L + DA_OFF_V + (8 * ch) * DA_VT + key * 2);
            vt[0 * (DA_VT / 2)] = (bf16)(vv.x & 0xffff); vt[1 * (DA_VT / 2)] = (bf16)(vv.x >> 16); vt[2 * (DA_VT / 2)] = (bf16)(vv.y & 0xffff); vt[3 * (DA_VT / 2)] = (bf16)(vv.y >> 16);
            vt[4 * (DA_VT / 2)] = (bf16)(vv.z & 0xffff); vt[5 * (DA_VT / 2)] = (bf16)(vv.z >> 16); vt[6 * (DA_VT / 2)] = (bf16)(vv.w & 0xffff); vt[7 * (DA_VT / 2)] = (bf16)(vv.w >> 16); }
        LBAR();
        if (k0 + 64 < kend) DA_LOAD(k0 + 64);
        if (k0 <= q0 + 31) {
            f32x16 st[2];
#pragma unroll
            for (int kt = 0; kt < 2; ++kt) { zero16(st[kt]);
#pragma unroll
                for (int ks = 0; ks < 4; ++ks) { const bf16x8 a = lds_rd16(L + DA_OFF_K + (32 * kt + l31) * DA_KS + (map * 64 + 16 * ks + 8 * h) * 2); st[kt] = MFMA32(a, qf[ks], st[kt]); } }
            const bool diag = (k0 + 63 > q0);
            float mx = -INFINITY;
            if (diag) {
#pragma unroll
                for (int kt = 0; kt < 2; ++kt)
#pragma unroll
                    for (int i = 0; i < 16; ++i) { if (k0 + 32 * kt + crow(i, h) > q0 + l31) st[kt][i] = -INFINITY; } }
#pragma unroll
            for (int kt = 0; kt < 2; ++kt)
#pragma unroll
                for (int i = 0; i < 16; ++i) mx = fmaxf(mx, st[kt][i]);
            mx = fmaxf(mx, __shfl_xor(mx, 32));
            const float mnew = fmaxf(mrun, mx), alpha = __builtin_amdgcn_exp2f((mrun - mnew) * sc), nm = -mnew * sc;
            float rs = 0.f;
#pragma unroll
            for (int kt = 0; kt < 2; ++kt)
#pragma unroll
                for (int i = 0; i < 16; ++i) { const float p = __builtin_amdgcn_exp2f(__builtin_fmaf(st[kt][i], sc, nm)); st[kt][i] = p; rs += p; }
            rs += __shfl_xor(rs, 32);
            lrun = lrun * alpha + rs; mrun = mnew;
            if (__ballot(alpha != 1.f) != 0ull) {
#pragma unroll
                for (int mt = 0; mt < 4; ++mt)
#pragma unroll
                    for (int i = 0; i < 16; ++i) o[mt][i] *= alpha; }
#pragma unroll
            for (int kt = 0; kt < 2; ++kt)
#pragma unroll
                for (int s2 = 0; s2 < 2; ++s2) { const bf16x8 pb = pack8(st[kt], s2);
#pragma unroll
                    for (int mt = 0; mt < 4; ++mt) { const bf16x8 a = lds_rd8x2(L + DA_OFF_V + (32 * mt + l31) * DA_VT + (32 * kt + 16 * s2 + 4 * h) * 2); o[mt] = MFMA32(a, pb, o[mt]); } }
        }
    }
    const float inv = (map == 0 ? 1.f : lam) / lrun;
    LAS float* cbuf = (LAS float*)(L + DA_OFF_C) + wq * 4096 + lane;
    if (map == 1) {
#pragma unroll
        for (int mt = 0; mt < 4; ++mt)
#pragma unroll
            for (int i = 0; i < 16; ++i) cbuf[(mt * 16 + i) * 64] = o[mt][i] * inv;
    }
    __syncthreads();
    if (map == 0) {
        float ss = 0.f;
#pragma unroll
        for (int mt = 0; mt < 4; ++mt)
#pragma unroll
            for (int i = 0; i < 16; ++i) { const float v = o[mt][i] * inv - cbuf[(mt * 16 + i) * 64]; o[mt][i] = v; ss += v * v; }
        ss += __shfl_xor(ss, 32);
        const float r = rsqrtf(ss * (1.f / 128.f) + 1e-6f) * 0.8f;
        bf16* orow = Omix + tq * 1024 + hh * 128;
#pragma unroll
        for (int mt = 0; mt < 4; ++mt)
#pragma unroll
            for (int g4 = 0; g4 < 4; ++g4) { const int dv = 32 * mt + 8 * g4 + 4 * h; const f32x4 gn = *(const f32x4*)(gnorm + dv);
                u32x2 w; w.x = cvtpk(o[mt][4 * g4] * r * gn[0], o[mt][4 * g4 + 1] * r * gn[1]); w.y = cvtpk(o[mt][4 * g4 + 2] * r * gn[2], o[mt][4 * g4 + 3] * r * gn[3]);
                *(u32x2*)(orow + dv) = w; }
    }
}
constexpr int GL_QS = 0, GL_KS = 64 * 144, GL_KH = 2 * 64 * 144, GL_VT = 3 * 64 * 144, GL_ST = GL_VT + 128 * 144, GL_TOT = GL_ST + 128 * 144, GL_BL = GL_TOT + 8 * 64 * 4, GL_SS = GL_BL + 256;
#define GLA_GATES(bl, tot) \
    float bl[8]; float tot = 0.f; { float run = 0.f; \
        _Pragma("unroll") for (int j = 0; j < 8; ++j) { const f32x4* gl = (const f32x4*)(G16 + (t0 + 8 * wave + j) * 16); float x = b2r; \
            _Pragma("unroll") for (int r4 = 0; r4 < 4; ++r4) { const f32x4 gq = gl[r4]; x += gq[0] * w2r[4 * r4] + gq[1] * w2r[4 * r4 + 1] + gq[2] * w2r[4 * r4 + 2] + gq[3] * w2r[4 * r4 + 3]; } \
            const float ls = fminf(x, 0.f) - __logf(1.f + __expf(-fabsf(x))); run += ls * (1.f / 16.f); bl[j] = run; } \
        __syncthreads(); \
        ((LAS float*)(L + GL_TOT))[wave * 64 + lane] = run; \
        __syncthreads(); \
        float pre = 0.f; \
        _Pragma("unroll") for (int w = 0; w < 8; ++w) { const float x = ((LAS float*)(L + GL_TOT))[w * 64 + lane]; tot += x; if (w < wave) pre += x; } \
        _Pragma("unroll") for (int j = 0; j < 8; ++j) bl[j] += pre; }
#define GLA_STAGE_VT() \
    _Pragma("unroll") for (int i = 0; i < 2; ++i) { const int c = tid + 512 * i, key = c & 63, ch = c >> 6; \
        const u32x4 vv = *(const u32x4*)(Hin + (t0 + key) * 3072 + 2048 + hh * 128 + 8 * ch); \
        LAS bf16* vtp = (LAS bf16*)(L + GL_VT + (8 * ch) * 144 + key * 2); \
        vtp[0 * 72] = (bf16)(vv.x & 0xffff); vtp[1 * 72] = (bf16)(vv.x >> 16); vtp[2 * 72] = (bf16)(vv.y & 0xffff); vtp[3 * 72] = (bf16)(vv.y >> 16); \
        vtp[4 * 72] = (bf16)(vv.z & 0xffff); vtp[5 * 72] = (bf16)(vv.z >> 16); vtp[6 * 72] = (bf16)(vv.w & 0xffff); vtp[7 * 72] = (bf16)(vv.w >> 16); }
DI void gla_passA_unit(const bf16* Hin, const float* G16, const float* w2, const float* b2, float* LOC, float* DEC, LAS unsigned char* L, int b, int hh, int n) {
    const int tid = tid_(), wave = __builtin_amdgcn_readfirstlane(tid >> 6), lane = tid & 63, l31 = lane & 31, h = lane >> 5;
    const int vt = wave & 3, tt = wave >> 2;
    float w2r[16];
#pragma unroll
    for (int r = 0; r < 16; ++r) w2r[r] = w2[r * 256 + hh * 64 + lane];
    const float b2r = b2[hh * 64 + lane];
    const size_t t0 = (size_t)b * SEQ + 64 * n;
    const int unit = (b * 4 + hh) * 32 + n;
    GLA_GATES(bl, tot)
    if (wave == 0) DEC[(size_t)unit * 64 + lane] = __expf(tot);
#pragma unroll
    for (int j = 0; j < 8; ++j) { const int t = 8 * wave + j;
        const float kv = bf2f(Hin[(t0 + t) * 3072 + 1792 + hh * 64 + lane]);
        ((LAS bf16*)(L + GL_KH + lane * 144))[t] = f2bf(kv * __expf(tot - bl[j])); }
    GLA_STAGE_VT()
    __syncthreads();
    f32x16 S; zero16(S);
#pragma unroll
    for (int ks = 0; ks < 4; ++ks) { const bf16x8 a = lds_rd16(L + GL_VT + (32 * vt + l31) * 144 + (16 * ks + 8 * h) * 2); const bf16x8 bb = lds_rd16(L + GL_KH + (32 * tt + l31) * 144 + (16 * ks + 8 * h) * 2); S = MFMA32(a, bb, S); }
    float* loc = LOC + (size_t)unit * 8192;
#pragma unroll
    for (int i = 0; i < 16; ++i) loc[(32 * vt + crow(i, h)) * 64 + 32 * tt + l31] = S[i];
}
DI void gla_passB(const float* LOC, const float* DEC, bf16* SST, int bh, int slice) {
    const int tid = tid_();
    const int e = slice * 1024 + tid * 2, d = e & 63;
    float s0 = 0.f, s1 = 0.f;
#pragma unroll 8
    for (int n = 0; n < 32; ++n) { const size_t unit = (size_t)bh * 32 + n;
        *(unsigned*)(SST + unit * 8192 + e) = cvtpk(s0, s1);
        const float2 l = *(const float2*)(LOC + unit * 8192 + e), dc = *(const float2*)(DEC + unit * 64 + d);
        s0 = s0 * dc.x + l.x; s1 = s1 * dc.y + l.y; }
}
DI void gla_passC_unit(const bf16* Hin, const float* G16, const float* w2, const float* b2, const float* gnorm, const bf16* SST, bf16* Omix, LAS unsigned char* L, int b, int hh, int n) {
    const int tid = tid_(), wave = __builtin_amdgcn_readfirstlane(tid >> 6), lane = tid & 63, l31 = lane & 31, h = lane >> 5;
    const int vt = wave & 3, tt = wave >> 2;
    float w2r[16];
#pragma unroll
    for (int r = 0; r < 16; ++r) w2r[r] = w2[r * 256 + hh * 64 + lane];
    const float b2r = b2[hh * 64 + lane];
    const size_t t0 = (size_t)b * SEQ + 64 * n;
    const int unit = (b * 4 + hh) * 32 + n;
    GLA_GATES(bl, tot)
    (void)tot;
#pragma unroll
    for (int j = 0; j < 8; ++j) { const int t = 8 * wave + j; const float bb = bl[j];
        const float qv = bf2f(Hin[(t0 + t) * 3072 + 1536 + hh * 64 + lane]), kv = bf2f(Hin[(t0 + t) * 3072 + 1792 + hh * 64 + lane]);
        ((LAS bf16*)(L + GL_QS + t * 144))[lane] = f2bf(qv * 0.125f * __expf(bb));
        ((LAS bf16*)(L + GL_KS + t * 144))[lane] = f2bf(kv * __expf(-bb)); }
    GLA_STAGE_VT()
#pragma unroll
    for (int i = 0; i < 2; ++i) { const int c = tid + 512 * i, v = c >> 3, ch = c & 7;
        *(LAS u32x4*)(L + GL_ST + v * 144 + ch * 16) = *(const u32x4*)(SST + (size_t)unit * 8192 + v * 64 + 8 * ch); }
    __syncthreads();
    bf16x8 qf[4];
#pragma unroll
    for (int ks = 0; ks < 4; ++ks) qf[ks] = lds_rd16(L + GL_QS + (32 * tt + l31) * 144 + (16 * ks + 8 * h) * 2);
    f32x16 at[2];
#pragma unroll
    for (int st = 0; st < 2; ++st) { zero16(at[st]);
#pragma unroll
        for (int ks = 0; ks < 4; ++ks) { const bf16x8 a = lds_rd16(L + GL_KS + (32 * st + l31) * 144 + (16 * ks + 8 * h) * 2); at[st] = MFMA32(a, qf[ks], at[st]); }
#pragma unroll
        for (int i = 0; i < 16; ++i) if (32 * st + crow(i, h) > 32 * tt + l31) at[st][i] = 0.f; }
    f32x16 oT; zero16(oT);
#pragma unroll
    for (int ks = 0; ks < 4; ++ks) { const bf16x8 a = lds_rd16(L + GL_ST + (32 * vt + l31) * 144 + (16 * ks + 8 * h) * 2); oT = MFMA32(a, qf[ks], oT); }
#pragma unroll
    for (int st = 0; st < 2; ++st)
#pragma unroll
        for (int s2 = 0; s2 < 2; ++s2) { const bf16x8 pb = pack8(at[st], s2); const bf16x8 a = lds_rd8x2(L + GL_VT + (32 * vt + l31) * 144 + (32 * st + 16 * s2 + 4 * h) * 2); oT = MFMA32(a, pb, oT); }
    float ss = 0.f;
#pragma unroll
    for (int i = 0; i < 16; ++i) ss += oT[i] * oT[i];
    ss += __shfl_xor(ss, 32);
    if (h == 0) ((LAS float*)(L + GL_SS))[wave * 32 + l31] = ss;
    __syncthreads();
    float tot2 = 0.f;
#pragma unroll
    for (int w = 0; w < 4; ++w) tot2 += ((LAS float*)(L + GL_SS))[(4 * tt + w) * 32 + l31];
    const float r = rsqrtf(tot2 * (1.f / 128.f) + 1e-6f);
    const size_t trow = t0 + 32 * tt + l31;
#pragma unroll
    for (int g4 = 0; g4 < 4; ++g4) { const int dv = 32 * vt + 8 * g4 + 4 * h; const f32x4 gn = *(const f32x4*)(gnorm + dv);
        const u32x2 rr = *(const u32x2*)(Hin + trow * 3072 + 2560 + hh * 128 + dv);
        const float r0 = siluf(bflo(rr.x)), r1 = siluf(bfhi(rr.x)), r2 = siluf(bflo(rr.y)), r3 = siluf(bfhi(rr.y));
        u32x2 w; w.x = cvtpk(oT[4 * g4] * r * gn[0] * r0, oT[4 * g4 + 1] * r * gn[1] * r1); w.y = cvtpk(oT[4 * g4 + 2] * r * gn[2] * r2, oT[4 * g4 + 3] * r * gn[3] * r3);
        *(u32x2*)(Omix + trow * 1024 + 512 + hh * 128 + dv) = w; }
}
constexpr int XA_KS = 528, XA_VT = 144, XA_OFF_V = 64 * XA_KS;
DI void xattn_unit(const bf16* Q, const bf16* KVm, bf16* Oxa, LAS unsigned char* L, int b, int hd, int qb) {
    const int tid = tid_(), wave = __builtin_amdgcn_readfirstlane(tid >> 6), lane = tid & 63, l31 = lane & 31, h = lane >> 5;
    const size_t tq = (size_t)b * SEQ + qb * 256 + wave * 32 + l31;
    f32x16 st[8];
    u32x4 pk[4];
#define XA_KLOAD(kb_) do { _Pragma("unroll") for (int i = 0; i < 4; ++i) { const int c = tid + 512 * i, key = c >> 5, ch = c & 31; \
        pk[i] = *(const u32x4*)(KVm + (size_t)(b * 256 + (kb_) * 64 + key) * 2048 + hd * 256 + 8 * ch); } } while (0)
    XA_KLOAD(0);
#pragma unroll
    for (int kb = 0; kb < 4; ++kb) {
        LBAR();
#pragma unroll
        for (int i = 0; i < 4; ++i) { const int c = tid + 512 * i, key = c >> 5, ch = c & 31; *(LAS u32x4*)(L + key * XA_KS + ch * 16) = pk[i]; }
        LBAR();
        if (kb < 3) XA_KLOAD(kb + 1);
        zero16(st[2 * kb]); zero16(st[2 * kb + 1]);
#pragma unroll
        for (int hf = 0; hf < 2; ++hf) { bf16x8 qf[8];
#pragma unroll
            for (int ks = 0; ks < 8; ++ks) qf[ks] = *(const bf16x8*)(Q + tq * 1024 + hd * 256 + 16 * (8 * hf + ks) + 8 * h);
#pragma unroll
            for (int kt = 0; kt < 2; ++kt)
#pragma unroll
                for (int ks = 0; ks < 8; ++ks) { const bf16x8 a = lds_rd16(L + (32 * kt + l31) * XA_KS + (16 * (8 * hf + ks) + 8 * h) * 2); st[2 * kb + kt] = MFMA32(a, qf[ks], st[2 * kb + kt]); }
            asm volatile("" ::: "memory"); }
    }
    u32x4 pv[2];
#define XA_VLOAD(s_) do { _Pragma("unroll") for (int i = 0; i < 2; ++i) { const int c = tid + 512 * i, key = c & 63, ch = c >> 6; \
        pv[i] = *(const u32x4*)(KVm + (size_t)(b * 256 + ((s_) & 3) * 64 + key) * 2048 + 1024 + hd * 256 + ((s_) >> 2) * 128 + 8 * ch); } } while (0)
    XA_VLOAD(0);
    const float sc = 0.0625f * LOG2E;
    float mx = -INFINITY;
#pragma unroll
    for (int j = 0; j < 8; ++j)
#pragma unroll
        for (int i = 0; i < 16; ++i) mx = fmaxf(mx, st[j][i]);
    mx = fmaxf(mx, __shfl_xor(mx, 32));
    const float nmx = -mx * sc;
    float rs = 0.f;
#pragma unroll
    for (int j = 0; j < 8; ++j)
#pragma unroll
        for (int i = 0; i < 16; ++i) { const float p = __builtin_amdgcn_exp2f(__builtin_fmaf(st[j][i], sc, nmx)); st[j][i] = p; rs += p; }
    rs += __shfl_xor(rs, 32);
    const float inv = 1.f / rs;
    bf16x8 pb[8][2];
#pragma unroll
    for (int j = 0; j < 8; ++j) {
#pragma unroll
        for (int i = 0; i < 16; ++i) st[j][i] *= inv;
        pb[j][0] = pack8(st[j], 0); pb[j][1] = pack8(st[j], 1); }
    f32x16 o[4];
#pragma unroll
    for (int s8 = 0; s8 < 8; ++s8) {
        const int dvh = s8 >> 2, kb = s8 & 3;
        if (kb == 0) {
#pragma unroll
            for (int mt = 0; mt < 4; ++mt) zero16(o[mt]); }
        LBAR();
#pragma unroll
        for (int i = 0; i < 2; ++i) { const int c = tid + 512 * i, key = c & 63, ch = c >> 6; const u32x4 vv = pv[i];
            LAS bf16* vtp = (LAS bf16*)(L + XA_OFF_V + (8 * ch) * XA_VT + key * 2);
            vtp[0 * 72] = (bf16)(vv.x & 0xffff); vtp[1 * 72] = (bf16)(vv.x >> 16); vtp[2 * 72] = (bf16)(vv.y & 0xffff); vtp[3 * 72] = (bf16)(vv.y >> 16);
            vtp[4 * 72] = (bf16)(vv.z & 0xffff); vtp[5 * 72] = (bf16)(vv.z >> 16); vtp[6 * 72] = (bf16)(vv.w & 0xffff); vtp[7 * 72] = (bf16)(vv.w >> 16); }
        LBAR();
        if (s8 < 7) XA_VLOAD(s8 + 1);
#pragma unroll
        for (int mt = 0; mt < 4; ++mt)
#pragma unroll
            for (int kt = 0; kt < 2; ++kt)
#pragma unroll
                for (int s2 = 0; s2 < 2; ++s2) { const bf16x8 a = lds_rd8x2(L + XA_OFF_V + (32 * mt + l31) * XA_VT + (32 * kt + 16 * s2 + 4 * h) * 2); o[mt] = MFMA32(a, pb[2 * kb + kt][s2], o[mt]); }
        if (kb == 3) {
            bf16* orow = Oxa + tq * 1024 + hd * 256 + dvh * 128;
#pragma unroll
            for (int mt = 0; mt < 4; ++mt)
#pragma unroll
                for (int g4 = 0; g4 < 4; ++g4) { const int dv = 32 * mt + 8 * g4 + 4 * h;
                    u32x2 w; w.x = cvtpk(o[mt][4 * g4], o[mt][4 * g4 + 1]); w.y = cvtpk(o[mt][4 * g4 + 2], o[mt][4 * g4 + 3]); *(u32x2*)(orow + dv) = w; } }
    }
}
constexpr int GP_KN = 0, GP_M = 64 * 272, GP_U0 = GP_M + 64 * 68 * 4, GP_W0 = GP_U0 + 64 * 128 * 4, GP_GT = GP_W0 + 64 * 128 * 4;
DI void gdn_prep_unit(bf16* Hin, float* G16, const bf16* halo, const float* convw, const float* a_log, const float* dt_bias, bf16* Wb, LAS unsigned char* L, int b, int n, int hd, bool dry, unsigned* flag) {
    const int tid = tid_(), wave = __builtin_amdgcn_readfirstlane(tid >> 6), lane = tid & 63, l31 = lane & 31, h = lane >> 5;
    const size_t t0 = (size_t)b * SEQ + 64 * n;
    LAS float* gt = (LAS float*)(L + GP_GT);
    const int c8 = tid & 15, tr = tid >> 4;
    u32x4 raw[3][2][4];
#pragma unroll
    for (int which = 0; which < 3; ++which) { const int col = which * 1024 + hd * 128 + 8 * c8;
#pragma unroll
        for (int rr = 0; rr < 2; ++rr)
#pragma unroll
            for (int j = 0; j < 4; ++j) { const int ts = tr + 32 * rr - 3 + j; u32x4 v = {0u, 0u, 0u, 0u};
                if (ts >= 0) v = *(const u32x4*)(Hin + (t0 + ts) * 4096 + col);
                else if (n > 0) v = *(const u32x4*)(halo + ((size_t)(b * 32 + n - 1) * 3 + (ts + 3)) * 3072 + col);
                raw[which][rr][j] = v; } }
    float blv = 0.f, alv = 0.f;
    if (wave == 0) { blv = G16[(t0 + lane) * 16 + hd]; alv = G16[(t0 + lane) * 16 + 8 + hd]; }
    LBAR();
    if (wave == 0) {
        const float x = alv + dt_bias[hd];
        const float sp = fmaxf(x, 0.f) + __logf(1.f + __expf(-fabsf(x)));
        float g = -__expf(a_log[hd]) * sp;
#pragma unroll
        for (int o = 1; o < 64; o <<= 1) { const float y = __shfl_up(g, o); if (lane >= o) g += y; }
        gt[lane] = sigmoidf_(blv); gt[64 + lane] = g;
        if (!dry) __hip_atomic_store(G16 + (t0 + lane) * 16 + hd, g, __ATOMIC_RELAXED, __HIP_MEMORY_SCOPE_AGENT);
    }
    float res[2][3][8];
#pragma unroll
    for (int which = 0; which < 3; ++which) {
        const int col = which * 1024 + hd * 128 + 8 * c8;
        float wv[4][8];
#pragma unroll
        for (int j = 0; j < 4; ++j) { const f32x4 a = *(const f32x4*)(convw + (size_t)j * 3072 + col), bb = *(const f32x4*)(convw + (size_t)j * 3072 + col + 4);
#pragma unroll
            for (int e = 0; e < 4; ++e) { wv[j][e] = a[e]; wv[j][4 + e] = bb[e]; } }
#pragma unroll
        for (int rr = 0; rr < 2; ++rr) { float acc[8];
#pragma unroll
            for (int e = 0; e < 8; ++e) acc[e] = 0.f;
#pragma unroll
            for (int j = 0; j < 4; ++j) { float xf[8]; unpack8(raw[which][rr][j], xf);
#pragma unroll
                for (int e = 0; e < 8; ++e) acc[e] += wv[j][e] * xf[e]; }
#pragma unroll
            for (int e = 0; e < 8; ++e) res[rr][which][e] = siluf(acc[e]); }
    }
#pragma unroll
    for (int rr = 0; rr < 2; ++rr)
#pragma unroll
        for (int which = 0; which < 2; ++which) { float ss = 0.f;
#pragma unroll
            for (int e = 0; e < 8; ++e) ss += res[rr][which][e] * res[rr][which][e];
            ss += __shfl_xor(ss, 1); ss += __shfl_xor(ss, 2); ss += __shfl_xor(ss, 4); ss += __shfl_xor(ss, 8);
            const float r = rsqrtf(ss + 1e-6f) * (which == 0 ? 0.08838834764831845f : 1.f);
#pragma unroll
            for (int e = 0; e < 8; ++e) res[rr][which][e] *= r; }
    LBAR();
#pragma unroll
    for (int rr = 0; rr < 2; ++rr) { const int t = tr + 32 * rr; const float beta = gt[t], eg = __expf(gt[64 + t]);
        if (!dry) st16_wt(Hin + (t0 + t) * 4096 + hd * 128 + 8 * c8, packf8(res[rr][0]));
        const u32x4 kp = packf8(res[rr][1]);
        if (!dry) st16_wt(Hin + (t0 + t) * 4096 + 1024 + hd * 128 + 8 * c8, kp);
        *(LAS u32x4*)(L + GP_KN + t * 272 + c8 * 16) = kp;
        float kq[8]; unpack8(kp, kq);
        f32x4 u0a, u0b, w0a, w0b;
#pragma unroll
        for (int e = 0; e < 4; ++e) { u0a[e] = res[rr][2][e] * beta; u0b[e] = res[rr][2][4 + e] * beta; w0a[e] = kq[e] * beta * eg; w0b[e] = kq[4 + e] * beta * eg; }
        *(LAS f32x4*)(L + GP_U0 + (t * 128 + 8 * c8) * 4) = u0a; *(LAS f32x4*)(L + GP_U0 + (t * 128 + 8 * c8 + 4) * 4) = u0b;
        *(LAS f32x4*)(L + GP_W0 + (t * 128 + 8 * c8) * 4) = w0a; *(LAS f32x4*)(L + GP_W0 + (t * 128 + 8 * c8 + 4) * 4) = w0b; }
    LBAR();
    if (wave < 4) { const int mt = wave >> 1, nt = wave & 1; f32x16 c; zero16(c);
        if (!(mt == 0 && nt == 1)) {
#pragma unroll
            for (int ks = 0; ks < 8; ++ks) { const bf16x8 a = lds_rd16(L + GP_KN + (32 * mt + l31) * 272 + (16 * ks + 8 * h) * 2); const bf16x8 bb = lds_rd16(L + GP_KN + (32 * nt + l31) * 272 + (16 * ks + 8 * h) * 2); c = MFMA32(a, bb, c); } }
        const int s = 32 * nt + l31; const float gs = gt[64 + s];
#pragma unroll
        for (int g4 = 0; g4 < 4; ++g4) { f32x4 mv;
#pragma unroll
            for (int e = 0; e < 4; ++e) { const int t = 32 * mt + 8 * g4 + 4 * h + e; mv[e] = (s < t) ? gt[t] * c[4 * g4 + e] * __expf(gt[64 + t] - gs) : 0.f; }
            *(LAS f32x4*)(L + GP_M + (s * 68 + 32 * mt + 8 * g4 + 4 * h) * 4) = mv; } }
    LBAR();
    if (tid < 256) {
        LAS float* rhs = (LAS float*)(L + (tid < 128 ? GP_U0 : GP_W0)) + (tid & 127);
        float r[64];
#pragma unroll
        for (int t = 0; t < 64; ++t) r[t] = rhs[t * 128];
#pragma unroll
        for (int s0 = 0; s0 < 63; ++s0) { if ((s0 & 3) == 0) asm volatile("" ::: "memory");
            const float xs = r[s0];
#pragma unroll
            for (int q4 = (s0 + 1) / 4; q4 < 16; ++q4) { const f32x4 m = *(LAS const f32x4*)(L + GP_M + (s0 * 68 + 4 * q4) * 4);
                r[4 * q4] -= m[0] * xs; r[4 * q4 + 1] -= m[1] * xs; r[4 * q4 + 2] -= m[2] * xs; r[4 * q4 + 3] -= m[3] * xs; } }
#pragma unroll
        for (int t = 0; t < 64; ++t) rhs[t * 128] = r[t];
    }
    LBAR();
#pragma unroll 1
    for (int i = 0; i < 2; ++i) { const int c = tid + 512 * i, t = c >> 4, ch = c & 15;
        float f[8];
#pragma unroll
        for (int e = 0; e < 8; ++e) f[e] = ((LAS const float*)(L + GP_U0))[t * 128 + 8 * ch + e];
        if (!dry) st16_wt(Hin + (t0 + t) * 4096 + 2048 + hd * 128 + 8 * ch, packf8(f));
#pragma unroll
        for (int e = 0; e < 8; ++e) f[e] = ((LAS const float*)(L + GP_W0))[t * 128 + 8 * ch + e];
        if (!dry) st16_wt(Wb + (t0 + t) * 1024 + hd * 128 + 8 * ch, packf8(f)); }
    if (flag != nullptr) {
        asm volatile("s_waitcnt vmcnt(0)" ::: "memory");
        __syncthreads();
        if (tid == 0) __hip_atomic_store(flag, 1u, __ATOMIC_RELAXED, __HIP_MEMORY_SCOPE_AGENT);
    }
}
constexpr int GS_W = 0, GS_Q = 64 * 272, GS_K = 2 * 64 * 272, GS_KG = 3 * 64 * 272, GS_ST = GS_KG + 128 * 144, GS_VN = GS_ST + 128 * 272, GS_GC = GS_VN + 128 * 144, GS_SS = GS_GC + 256;
#define GS_LOAD(nn) do { const size_t t0n = (size_t)b * SEQ + 64 * (nn); \
    _Pragma("unroll") for (int i = 0; i < 2; ++i) { const int c = tid + 512 * i, t = c & 63, ch = c >> 6; \
        pw[i] = *(const u32x4*)(Wb + (t0n + t) * 1024 + hd * 128 + 8 * ch); pq[i] = *(const u32x4*)(Hin + (t0n + t) * 4096 + hd * 128 + 8 * ch); \
        pk[i] = *(const u32x4*)(Hin + (t0n + t) * 4096 + 1024 + hd * 128 + 8 * ch); pgk[i] = G16[(t0n + t) * 16 + hd]; } \
    pgc = G16[(t0n + (tid & 63)) * 16 + hd]; pgl = G16[(t0n + 63) * 16 + hd]; \
    { const size_t trn = t0n + 32 * tt + l31; \
      _Pragma("unroll") for (int g4 = 0; g4 < 4; ++g4) { pu[g4] = *(const u32x2*)(Hin + trn * 4096 + 2048 + hd * 128 + 32 * vt + 8 * g4 + 4 * h); pz[g4] = *(const u32x2*)(Hin + trn * 4096 + 3072 + hd * 128 + 32 * vt + 8 * g4 + 4 * h); } } } while (0)
DI void gdn_scan_unit(bf16* Hin, const float* G16, const bf16* Wb, const float* gnorm, LAS unsigned char* L, int b, int hd, bool dry, unsigned* flags) {
    const int tid = tid_(), wave = __builtin_amdgcn_readfirstlane(tid >> 6), lane = tid & 63, l31 = lane & 31, h = lane >> 5;
    const int vt = wave & 3, tt = wave >> 2;
    f32x16 S[2]; zero16(S[0]); zero16(S[1]);
    __syncthreads();
    for (int i = tid; i < 128 * 272 / 4; i += 512) ((LAS unsigned*)(L + GS_ST))[i] = 0u;
    LAS float* gcs = (LAS float*)(L + GS_GC);
    u32x4 pw[2], pq[2], pk[2]; float pgk[2], pgc, pgl; u32x2 pu[4], pz[4];
#define GS_WAIT(nn) do { if (flags != nullptr && tid == 0) { unsigned* f_ = flags + (b * 8 + hd) * 32 + (nn); unsigned sp_ = 0; \
        while (__hip_atomic_load(f_, __ATOMIC_RELAXED, __HIP_MEMORY_SCOPE_AGENT) == 0u) { __builtin_amdgcn_s_sleep(2); if (++sp_ > (1u << 24)) break; } \
        __builtin_amdgcn_fence(__ATOMIC_ACQUIRE, "agent"); asm volatile("s_waitcnt vmcnt(0)" ::: "memory"); } } while (0)
    GS_WAIT(0);
    __syncthreads();
    GS_LOAD(0);
    for (int n = 0; n < 32; ++n) {
        const size_t t0 = (size_t)b * SEQ + 64 * n;
        if (n < 31) GS_WAIT(n + 1);
        LBAR();
        const float gl = pgl;
        if (tid < 64) gcs[tid] = pgc;
#pragma unroll
        for (int i = 0; i < 2; ++i) { const int c = tid + 512 * i, t = c & 63, ch = c >> 6;
            *(LAS u32x4*)(L + GS_W + t * 272 + ch * 16) = pw[i];
            *(LAS u32x4*)(L + GS_Q + t * 272 + ch * 16) = pq[i];
            *(LAS u32x4*)(L + GS_K + t * 272 + ch * 16) = pk[i];
            float kf[8]; unpack8(pk[i], kf); const float e = __expf(gl - pgk[i]);
            LAS bf16* kg = (LAS bf16*)(L + GS_KG + (8 * ch) * 144 + t * 2);
#pragma unroll
            for (int j = 0; j < 8; ++j) kg[j * 72] = f2bf(kf[j] * e); }
        u32x2 cu[4], cz[4];
#pragma unroll
        for (int g4 = 0; g4 < 4; ++g4) { cu[g4] = pu[g4]; cz[g4] = pz[g4]; }
        LBAR();
        if (n < 31) GS_LOAD(n + 1);
        f32x16 vn; zero16(vn);
#pragma unroll
        for (int ks = 0; ks < 8; ++ks) { const bf16x8 a = lds_rd16(L + GS_ST + (32 * vt + l31) * 272 + (16 * ks + 8 * h) * 2); const bf16x8 bb = lds_rd16(L + GS_W + (32 * tt + l31) * 272 + (16 * ks + 8 * h) * 2); vn = MFMA32(a, bb, vn); }
#pragma unroll
        for (int g4 = 0; g4 < 4; ++g4) { const u32x2 uu = cu[g4];
            vn[4 * g4] = bflo(uu.x) - vn[4 * g4]; vn[4 * g4 + 1] = bfhi(uu.x) - vn[4 * g4 + 1]; vn[4 * g4 + 2] = bflo(uu.y) - vn[4 * g4 + 2]; vn[4 * g4 + 3] = bfhi(uu.y) - vn[4 * g4 + 3]; }
#pragma unroll
        for (int i = 0; i < 16; ++i) ((LAS bf16*)(L + GS_VN + (32 * vt + crow(i, h)) * 144))[32 * tt + l31] = f2bf(vn[i]);
        bf16x8 qf[8];
#pragma unroll
        for (int ks = 0; ks < 8; ++ks) qf[ks] = lds_rd16(L + GS_Q + (32 * tt + l31) * 272 + (16 * ks + 8 * h) * 2);
        const float gct = gcs[32 * tt + l31];
        f32x16 X[2];
#pragma unroll
        for (int st = 0; st < 2; ++st) { zero16(X[st]);
#pragma unroll
            for (int ks = 0; ks < 8; ++ks) { const bf16x8 a = lds_rd16(L + GS_K + (32 * st + l31) * 272 + (16 * ks + 8 * h) * 2); X[st] = MFMA32(a, qf[ks], X[st]); }
#pragma unroll
            for (int i = 0; i < 16; ++i) { const int s = 32 * st + crow(i, h); X[st][i] = (s <= 32 * tt + l31) ? X[st][i] * __expf(gct - gcs[s]) : 0.f; } }
        f32x16 oT; zero16(oT);
#pragma unroll
        for (int ks = 0; ks < 8; ++ks) { const bf16x8 a = lds_rd16(L + GS_ST + (32 * vt + l31) * 272 + (16 * ks + 8 * h) * 2); oT = MFMA32(a, qf[ks], oT); }
        { const float eg = __expf(gct);
#pragma unroll
          for (int i = 0; i < 16; ++i) oT[i] *= eg; }
        LBAR();
#pragma unroll
        for (int st = 0; st < 2; ++st)
#pragma unroll
            for (int s2 = 0; s2 < 2; ++s2) { const bf16x8 pb = pack8(X[st], s2); const bf16x8 a = lds_rd8x2(L + GS_VN + (32 * vt + l31) * 144 + (32 * st + 16 * s2 + 4 * h) * 2); oT = MFMA32(a, pb, oT); }
        float ss = 0.f;
#pragma unroll
        for (int i = 0; i < 16; ++i) ss += oT[i] * oT[i];
        ss += __shfl_xor(ss, 32);
        if (h == 0) ((LAS float*)(L + GS_SS))[wave * 32 + l31] = ss;
        { const float eg = __expf(gl);
#pragma unroll
          for (int j = 0; j < 2; ++j) {
#pragma unroll
              for (int i = 0; i < 16; ++i) S[j][i] *= eg;
#pragma unroll
              for (int ks = 0; ks < 4; ++ks) { const bf16x8 a = lds_rd16(L + GS_VN + (32 * vt + l31) * 144 + (16 * ks + 8 * h) * 2); const bf16x8 bb = lds_rd16(L + GS_KG + (32 * (2 * tt + j) + l31) * 144 + (16 * ks + 8 * h) * 2); S[j] = MFMA32(a, bb, S[j]); } } }
        LBAR();
        { float tot2 = 0.f;
#pragma unroll
          for (int w = 0; w < 4; ++w) tot2 += ((LAS float*)(L + GS_SS))[(4 * tt + w) * 32 + l31];
          const float r = rsqrtf(tot2 * (1.f / 128.f) + 1e-6f);
          const size_t trow = t0 + 32 * tt + l31;
#pragma unroll
          for (int g4 = 0; g4 < 4; ++g4) { const int dv = 32 * vt + 8 * g4 + 4 * h; const f32x4 gn = *(const f32x4*)(gnorm + dv);
              bf16* zp = Hin + trow * 4096 + 3072 + hd * 128 + dv;
              const u32x2 zz = cz[g4];
              const float z0 = siluf(bflo(zz.x)), z1 = siluf(bfhi(zz.x)), z2 = siluf(bflo(zz.y)), z3 = siluf(bfhi(zz.y));
              u32x2 w; w.x = cvtpk(oT[4 * g4] * r * gn[0] * z0, oT[4 * g4 + 1] * r * gn[1] * z1); w.y = cvtpk(oT[4 * g4 + 2] * r * gn[2] * z2, oT[4 * g4 + 3] * r * gn[3] * z3);
              if (!dry) *(u32x2*)zp = w; }
#pragma unroll
          for (int j = 0; j < 2; ++j)
#pragma unroll
              for (int i = 0; i < 16; ++i) ((LAS bf16*)(L + GS_ST + (32 * vt + crow(i, h)) * 272))[32 * (2 * tt + j) + l31] = f2bf(S[j][i]); }
    }
    __syncthreads();
}
#ifndef MK_MASK
#define MK_MASK 0xffff
#endif
#ifndef MK_PROBE
#define MK_PROBE 0
#endif
#define TIDS const int tid = tid_(), wave = __builtin_amdgcn_readfirstlane(tid >> 6), lane = tid & 63, gw = blk * 8 + wave, gtid = blk * 512 + tid; (void)gw; (void)gtid; (void)lane; (void)wave;

template <int layer>
DI void layer_body(const Args& args, const XcdBarrier& xbar, LAS unsigned char* L, int lo, int hi) {
    const int G = gridDim.x, blk = blockIdx.x;
    const int NGW = G * 8, gthreads = G * 512;
    unsigned char* ws = args.ws;
    float* rope = (float*)(ws + WS_ROPE); float* G16 = (float*)(ws + WS_G16); bf16* halo = (bf16*)(ws + WS_HALO);
    bf16* memb = (bf16*)(ws + WS_MEMB); bf16* KVm = (bf16*)(ws + WS_KVM); bf16* hb = (bf16*)(ws + WS_HB); bf16* big = (bf16*)(ws + WS_BIG); bf16* act = (bf16*)(ws + WS_ACT);
    float* out = args.out;
    constexpr int P = 16 * layer, cb = layer ? 29 : 10;
    float* lnstats = (float*)(ws + WS_BAR + 256 * 1024);
#define IN(k) (lo <= (k) && (k) < hi)
#define SEAM(k) do { if (IN(k) && IN((k) + 1)) xcd_barrier(xbar); } while (0)
        if (IN(P + 1)) {
            { TIDS for (int task = blk * 2 + wave; wave < 2 && task < T / 32; task += 2 * G) gate_cols(hb, (const bf16*)(ws + WS_WIN) + (size_t)(layer ? 4096 : 3072) * 1024, G16, task); }
            { const int N = layer ? 4096 : 3072;
              pg8::Gemm g{hb, (const bf16*)(ws + WS_WIN), T, N, 1024, 1024}; pg8::StaticOrder S; S.init(T, N, G, blk);
              pg8::EpiBf16 E{big, layer ? 4096 : 3072, layer ? 16 : 12, G16, layer ? halo : nullptr};
              if (MK_MASK & 128) pg8::gemm_phase<pg8::EpiBf16, pg8::StaticOrder, true, true>(L, g, S, E); }
            if (layer == 0 || G < 128) { pg8::Gemm g{memb, (const bf16*)(ws + WS_WKV), TM, 2048, 1024, 1024}; pg8::StaticOrder S; S.init(TM, 2048, G, blk);
              pg8::EpiBf16 E{KVm, 2048, 1 << 30, nullptr, nullptr};
              if (MK_MASK & 128) pg8::gemm_phase<pg8::EpiBf16, pg8::StaticOrder, true, true>(L, g, S, E); }
        }
        SEAM(P + 1);
        if (layer == 0) {
            if (IN(2)) {
                float* LOC = (float*)(ws + 184 * MiB); bf16* SST = (bf16*)(ws + 216 * MiB); float* DEC = (float*)(ws + 232 * MiB);
                for (int u = blk; u < 1024; u += G) gla_passA_unit(big, G16, inptr(6), inptr(7), LOC, DEC, L, u >> 7, (u >> 5) & 3, u & 31);
                { float lam; { TIDS const float* lf = inptr(4); const float a = wave_sum(lf[lane] * lf[64 + lane]), c = wave_sum(lf[128 + lane] * lf[192 + lane]); lam = __expf(a) - __expf(c) + 0.2f; }
                  for (int p = 0;; ++p) { const int u = (p & 1) ? (p + 1) * G - 1 - blk : p * G + blk; if (u >= 512 || p * G >= 512) break;
                      const int qb = 15 - (u >> 5), bh = u & 31; diffattn_unit(big, rope, inptr(5), hb, L, bh >> 2, bh & 3, qb, lam); } }
                xcd_barrier(xbar);
                for (int u = blk; u < 256; u += G) gla_passB(LOC, DEC, SST, u >> 3, u & 7);
                xcd_barrier(xbar);
                for (int u = blk; u < 1024; u += G) gla_passC_unit(big, G16, inptr(6), inptr(7), inptr(8), SST, hb, L, u >> 7, (u >> 5) & 3, u & 31);
            }
            SEAM(2);
        } else {
            unsigned* gflags = (unsigned*)(ws + WS_BAR) + 16384;
            const bool piped = (G >= 128);
            if (IN(P + 2)) {
                if (!piped) { for (int u = blk; u < 2048; u += G) gdn_prep_unit(big, G16, halo, inptr(24), inptr(25), inptr(26), hb, L, u >> 8, (u >> 3) & 31, u & 7, false, nullptr); }
                else if (blk >= 64) { for (int v = blk - 64; v < 2048; v += G - 64) { const int n = v >> 6, bh = v & 63; gdn_prep_unit(big, G16, halo, inptr(24), inptr(25), inptr(26), hb, L, bh >> 3, n, bh & 7, false, gflags + bh * 32 + n); } }
                else {
                    if (G != 256) { pg8::Gemm g{memb, (const bf16*)(ws + WS_WKV), TM, 2048, 1024, 1024}; pg8::StaticOrder S; S.init(TM, 2048, 64, blk);
                      pg8::EpiBf16 E{KVm, 2048, 1 << 30, nullptr, nullptr};
                      pg8::gemm_phase<pg8::EpiBf16, pg8::StaticOrder, true, true>(L, g, S, E); }
                    gdn_scan_unit(big, G16, hb, inptr(27), L, blk >> 3, blk & 7, false, gflags);
                }
            }
            SEAM(P + 2);
        }
        if (layer == 1 && G < 128) {
            if (IN(P + 3)) for (int u = blk; u < 64; u += G) gdn_scan_unit(big, G16, hb, inptr(27), L, u >> 3, u & 7, false, nullptr);
            SEAM(P + 3);
        }
        { const int ph = layer ? P + 4 : 3;
          if (IN(ph)) { pg8::Gemm g{layer ? big + 3072 : hb, (const bf16*)(ws + WS_WOUT), T, 1024, 1024, layer ? 4096 : 1024}; pg8::StaticOrder S; S.init(T, 1024, G, blk);
              pg8::EpiRes<layer == 1> E{layer ? out : inptr(0), out, lnstats, inptr(10 + 11), inptr(10 + 12), ALPHA, 0};
              pg8::gemm_phase<pg8::EpiRes<layer == 1>, pg8::StaticOrder, true, true>(L, g, S, E); }
          SEAM(ph); }
        const int Q0 = layer ? P + 5 : 4;
        if (IN(Q0)) { TIDS ln_apply(out, inptr(cb + 0), inptr(cb + 1), out, hb, lnstats, gw, NGW, lane); }
        SEAM(Q0);
        const bool qfuse = (G == 256);
        bf16* oxa = qfuse ? act : hb;
        if (IN(Q0 + 1)) { pg8::Gemm g{hb, (const bf16*)(ws + WS_WQ), T, 1024, 1024, 1024}; pg8::StaticOrder S; S.init(T, 1024, G, blk);
            pg8::EpiBf16 E{big, 1024, 1 << 30, nullptr, nullptr};
            pg8::gemm_phase<pg8::EpiBf16, pg8::StaticOrder, true, true>(L, g, S, E);
            if (qfuse) { int qpm, qpn; if (so_next(S, 0, qpm, qpn)) { asm volatile("s_waitcnt vmcnt(0)" ::: "memory"); __syncthreads(); xattn_unit(big, KVm, oxa, L, qpm >> 3, qpn, qpm & 7); } } }
        if (!qfuse) { SEAM(Q0 + 1);
            if (IN(Q0 + 2)) for (int u = blk; u < 256; u += G) xattn_unit(big, KVm, oxa, L, u >> 5, (u >> 3) & 3, u & 7); }
        SEAM(Q0 + 2);
        if (IN(Q0 + 3)) { pg8::Gemm g{oxa, (const bf16*)(ws + WS_WO), T, 1024, 1024, 1024}; pg8::StaticOrder S; S.init(T, 1024, G, blk);
            pg8::EpiRes<true> E{out, out, lnstats, inptr(cb + 0), inptr(cb + 1), ALPHA, 0};
            pg8::gemm_phase<pg8::EpiRes<true>, pg8::StaticOrder, true, true>(L, g, S, E); }
        SEAM(Q0 + 3);
        if (IN(Q0 + 4)) { TIDS ln_apply(out, inptr(cb + 5), inptr(cb + 6), out, hb, lnstats, gw, NGW, lane); }
        SEAM(Q0 + 4);
        if (IN(Q0 + 5)) { pg8::Gemm g{hb, (const bf16*)(ws + WS_WFI), T, 2 * DFF, 1024, 1024}; pg8::StaticOrder S; S.init(T, 2 * DFF, G, blk);
            pg8::EpiFfn E{big, inptr(cb + 8), inptr(cb + 9), (float*)(ws + WS_ACT), L + 131072};
            pg8::gemm_phase<pg8::EpiFfn, pg8::StaticOrder, true, true>(L, g, S, E);
            if (layer == 0 && G == 256 && blk >= 128 && blk < 192) {
                pg8::Gemm g2{memb, (const bf16*)(ws + WS_WKV1), TM, 2048, 1024, 1024}; pg8::StaticOrder S2; S2.init(TM, 2048, 64, blk - 128);
                pg8::EpiBf16 E2{KVm, 2048, 1 << 30, nullptr, nullptr};
                pg8::gemm_phase<pg8::EpiBf16, pg8::StaticOrder, true, true>(L, g2, S2, E2); } }
        SEAM(Q0 + 5);
        if (IN(Q0 + 5) && IN(Q0 + 7)) { pg8::Gemm g{big, (const bf16*)(ws + WS_WFOA), T, 1024, DFF, DFF}; pg8::StaticOrder S; S.init(T, 1024, G, blk);
            { TIDS int fpm, fpn; for (int i = 0; so_next(S, i, fpm, fpn); ++i) ffn_fix((const float*)(ws + WS_ACT), big, inptr(cb + 8), inptr(cb + 9), fpm, tid);
              asm volatile("s_waitcnt vmcnt(0)" ::: "memory"); __syncthreads(); }
            pg8::EpiRes<true> E{out, out, lnstats, inptr(cb + 5), inptr(cb + 6), ALPHA, 0};
            pg8::gemm_phase<pg8::EpiRes<true>, pg8::StaticOrder, true, true>(L, g, S, E); }
        SEAM(Q0 + 7);
        const int LN3 = Q0 + 8;
        if (IN(LN3)) { TIDS ln_apply(out, inptr(cb + 11), inptr(cb + 12), out, layer ? nullptr : hb, layer ? nullptr : lnstats, gw, NGW, lane);
            if (layer == 0) { if (MK_MASK & 1) convert_weights(args, 1, L, gw, NGW, wave, lane); } }
        if (layer == 0) SEAM(LN3);

#undef IN
#undef SEAM
}
#ifndef MK_CG_SEAM0
#define MK_CG_SEAM0 0
#endif
#ifndef MK_PER_PHASE
#define MK_PER_PHASE 0
#endif
#ifndef MK_MASK
#define MK_MASK 0xffff
#endif
#ifndef MK_PROBE
#define MK_PROBE 0
#endif
constexpr int NPHASE = 33;
__global__ void __launch_bounds__(512, 2) mk_fwd(Args args) {
    extern __shared__ __attribute__((aligned(16))) unsigned char lds_raw[];
    LAS unsigned char* L = (LAS unsigned char*)lds_raw;
    const int G = gridDim.x, blk = blockIdx.x;
    const int NGW = G * 8, gthreads = G * 512;
    unsigned char* ws = args.ws;
    float* rope = (float*)(ws + WS_ROPE); float* G16 = (float*)(ws + WS_G16); bf16* halo = (bf16*)(ws + WS_HALO);
    bf16* memb = (bf16*)(ws + WS_MEMB); bf16* KVm = (bf16*)(ws + WS_KVM); bf16* hb = (bf16*)(ws + WS_HB); bf16* big = (bf16*)(ws + WS_BIG); bf16* act = (bf16*)(ws + WS_ACT);
    const int lo = args.ph_lo, hi = args.ph_hi;
    volatile LAS unsigned* xst = (volatile LAS unsigned*)(L + LDS_BYTES - 16);
    if (threadIdx.x < 4) xst[threadIdx.x] = 0u;
    __syncthreads();
    const XcdBarrier xbar = xcd_barrier_post((unsigned*)(ws + WS_BAR), xst);
#define IN(k) (lo <= (k) && (k) < hi)
#define SEAM(k) do { if (IN(k) && IN((k) + 1)) xcd_barrier(xbar); } while (0)
    float* out = args.out;
    if (IN(0)) { TIDS
        if (MK_MASK & 1) convert_weights(args, 0, L, gw, NGW, wave, lane);
        to_bf16(inptr(0), hb, (size_t)T * D, gtid, gthreads);
        to_bf16(inptr(1), memb, (size_t)TM * D, gtid, gthreads);
        { LAS float* scr = (LAS float*)(L + wave * 16384); const float* wkv1 = inptr(29 + 3);
          for (int r = gw; r < 16 * 64; r += NGW) { const int kb = r / 64, n0 = 32 * (r % 64); transpose_item(wkv1, 2048, (bf16*)(ws + WS_WKV1), 1024, 64 * kb, n0, n0, 64 * kb, scr, lane); } }
        rope_table((const int*)inptr(2), rope, gtid, gthreads);
    }
#if MK_CG_SEAM0
    if (IN(0) && IN(1)) cg::this_grid().sync();
#else
    SEAM(0);
#endif
    layer_body<0>(args, xbar, L, lo, hi);
    layer_body<1>(args, xbar, L, lo, hi);
#undef IN
#undef SEAM
}

extern "C" void kernel_launch(void* const* d_in, const int* in_sizes, int n_in, void* d_out, int out_size, void* d_ws, size_t ws_size, hipStream_t stream) {
    static int grid = 0;
    if (grid == 0) {
        int dev = 0, cus = 0, per_cu = 0;
        hipGetDevice(&dev); hipDeviceGetAttribute(&cus, hipDeviceAttributeMultiprocessorCount, dev);
        hipFuncSetAttribute((const void*)mk_fwd, hipFuncAttributeMaxDynamicSharedMemorySize, LDS_BYTES);
        if (hipOccupancyMaxActiveBlocksPerMultiprocessor(&per_cu, (const void*)mk_fwd, 512, LDS_BYTES) != hipSuccess || per_cu < 1) { per_cu = 1; (void)hipGetLastError(); }
        grid = cus * per_cu; if (grid > 256) grid = 256;
        if (n_in != 42 || ws_size < 256 * MiB) fprintf(stderr, "kernel_launch: unexpected n_in %d / ws %zu\n", n_in, ws_size);
    }
    Args a{};
    for (int i = 0; i < 42; ++i) a.in[i] = (const float*)d_in[i];
    a.out = (float*)d_out; a.ws = (unsigned char*)d_ws;
    (void)hipMemsetAsync((unsigned char*)d_ws + WS_BAR, 0, 16384 * 4 + 2048 * 4, stream);
#if MK_PER_PHASE
    for (int p = 0; p < NPHASE; ++p) { a.ph_lo = p; a.ph_hi = p + 1; hipLaunchKernelGGL(mk_fwd, dim3(grid), dim3(512), LDS_BYTES, stream, a); }
#else
    a.ph_lo = 0; a.ph_hi = NPHASE;
    void* kargs[] = {&a};
    hipError_t e = hipLaunchCooperativeKernel((const void*)mk_fwd, dim3(grid), dim3(512), kargs, LDS_BYTES, stream);
    if (e != hipSuccess) fprintf(stderr, "cooperative launch failed: %s (grid %d)\n", hipGetErrorString(e), grid);
#endif
}
```

```cpp
#include <hip/hip_runtime.h>
#include <hip/hip_cooperative_groups.h>
#include <cstdio>
#include <cstdint>
namespace cg = cooperative_groups;
__device__ __forceinline__ int tid_() { int t = threadIdx.x; asm volatile("" : "+v"(t)); return t; }
namespace pg8 {
#define PG8_LAS __attribute__((address_space(3)))
typedef unsigned short bf16_t;
typedef short bf16x8 __attribute__((ext_vector_type(8)));
typedef float f32x4 __attribute__((ext_vector_type(4)));
typedef unsigned u32x4 __attribute__((ext_vector_type(4)));
typedef unsigned u32x2 __attribute__((ext_vector_type(2)));
constexpr int BM = 256, BK = 64, HALF = 128, HTB = HALF * BK * 2  , STAGE_BYTES = 8 * HTB, NXCD = 8, WGM = 8;

__host__ __device__ __forceinline__ int lds_byte(int r, int c) { const int st = (r >> 4) * 2 + (c >> 5), rr = r & 15, cc = c & 31, ob = rr * 64 + cc * 2; return st * 1024 + (ob ^ (((ob >> 9) & 1) << 5)); }
__host__ __device__ __forceinline__ void stage_rc(int b, int& R, int& C) { const int st = b / 1024, sb = b % 1024, swz = sb ^ (((sb >> 9) & 1) << 5); R = (st >> 1) * 16 + swz / 64; C = (st & 1) * 32 + (swz % 64) / 2; }
__host__ __device__ __forceinline__ int perm32(int rho) { const int n = rho >> 4, i = rho & 15; return 8 * (i >> 2) + 4 * n + (i & 3); }

struct Unit { int pm, pn; };
struct Gemm { const bf16_t* A; const bf16_t* Bt; int M, N, K, lda; };

struct StaticOrder {
    int nM, nN, nwg, G, c;
    __host__ __device__ void init(int M, int N, int G_, int c_) { nM = M / BM; nN = N / BM; nwg = nM * nN; G = G_; c = c_; }
    __host__ __device__ bool next(int i, Unit& u) const {
        const long L = (long)i * G + c; if (L >= nwg) return false;
        int wgid = (int)L; { const int q = nwg / NXCD, r = nwg % NXCD, xcd = wgid % NXCD, off = wgid / NXCD; wgid = (xcd < r ? xcd * (q + 1) : r * (q + 1) + (xcd - r) * q) + off; }
        const int nig = WGM * nN, gid = wgid / nig, fm = gid * WGM, gsz = (nM - fm) < WGM ? (nM - fm) : WGM;
        u.pm = fm + ((wgid % nig) % gsz); u.pn = (wgid % nig) / gsz; return true;
    }
    __device__ __forceinline__ void a_ready(const Unit&) const {}
    __device__ __forceinline__ void done(const Unit&) const {}
};
__device__ __forceinline__ unsigned cvt_pk_bf16(float lo, float hi) { typedef float f2 __attribute__((ext_vector_type(2))); typedef __bf16 b2 __attribute__((ext_vector_type(2))); f2 v = {lo, hi}; b2 b = __builtin_convertvector(v, b2); return __builtin_bit_cast(unsigned, b); }
struct EpiBf16 {
    static constexpr bool PERM = true, AFTER_DRAIN = false;
    bf16_t* O; int ldc; int gate_pn; float* G16; bf16_t* halo;
    __device__ __forceinline__ void operator()(const f32x4 (&acc)[2][2][4][2], const Unit& u, int wr, int wc, int fr, int fq) const {
        const int row0 = u.pm * BM + wr * 64 + fr;
        if (u.pn >= gate_pn) {
            if (wc == 0 && fq < 2) {
#pragma unroll
                for (int ai = 0; ai < 2; ++ai)
#pragma unroll
                    for (int m = 0; m < 4; ++m) { float* p = G16 + (size_t)(row0 + ai * HALF + m * 16) * 16 + 8 * fq;
                        *(f32x4*)p = acc[ai][0][m][0]; *(f32x4*)(p + 4) = acc[ai][0][m][1]; }
            }
            return;
        }
        const int col0 = u.pn * BM + wc * 32 + 8 * fq;
#pragma unroll
        for (int ai = 0; ai < 2; ++ai)
#pragma unroll
            for (int m = 0; m < 4; ++m) { const int row = row0 + ai * HALF + m * 16; bf16_t* rowp = O + (size_t)row * ldc + col0;
#pragma unroll
                for (int bj = 0; bj < 2; ++bj) { const f32x4 v0 = acc[ai][bj][m][0], v1 = acc[ai][bj][m][1];
                    u32x4 w; w.x = cvt_pk_bf16(v0[0], v0[1]); w.y = cvt_pk_bf16(v0[2], v0[3]); w.z = cvt_pk_bf16(v1[0], v1[1]); w.w = cvt_pk_bf16(v1[2], v1[3]);
                    *(u32x4*)(rowp + bj * HALF) = w;
                    if (halo != nullptr && m == 3 && fr >= 13 && (col0 + bj * HALF) < 3072) *(u32x4*)(halo + ((size_t)(row >> 6) * 3 + (fr - 13)) * 3072 + col0 + bj * HALF) = w; } }
    }
};

__device__ __forceinline__ float dpp_ror1(float v) { return __builtin_bit_cast(float, __builtin_amdgcn_update_dpp(0, __builtin_bit_cast(int, v), 0x121, 0xf, 0xf, false)); }
__device__ __forceinline__ float dpp_ror2(float v) { return __builtin_bit_cast(float, __builtin_amdgcn_update_dpp(0, __builtin_bit_cast(int, v), 0x122, 0xf, 0xf, false)); }
struct EpiFfn {
    static constexpr bool PERM = true, AFTER_DRAIN = false;
    bf16_t* Act; const float* cw; const float* cbias; float* RAW; PG8_LAS unsigned char* xch;
    __device__ __forceinline__ void operator()(const f32x4 (&acc)[2][2][4][2], const Unit& u, int wr, int wc, int fr, int fq) const {
        const int c8 = wc * 32 + 8 * fq;
        const int ch = u.pn * 128 + c8;
        if (fr >= 14) {
#pragma unroll
            for (int ai = 0; ai < 2; ++ai)
#pragma unroll
                for (int bj = 0; bj < 2; ++bj)
#pragma unroll
                    for (int n = 0; n < 2; ++n) *(PG8_LAS f32x4*)(xch + ((((ai * 2 + wr) * 2 + (fr - 14)) * 256) + bj * 128 + c8 + 4 * n) * 4) = acc[ai][bj][3][n];
        }
        asm volatile("s_waitcnt lgkmcnt(0)" ::: "memory"); __builtin_amdgcn_s_barrier(); asm volatile("" ::: "memory");
        if (wr == 0 && fr < 2) {
#pragma unroll
            for (int n = 0; n < 2; ++n) { float* p = RAW + ((size_t)u.pm * 4 + fr) * 5632 + ch + 4 * n; *(f32x4*)p = acc[0][0][0][n]; *(f32x4*)(p + 2816) = acc[0][1][0][n]; } }
        if (wr == 1 && fr >= 14) {
#pragma unroll
            for (int n = 0; n < 2; ++n) { float* p = RAW + ((size_t)u.pm * 4 + 2 + (fr - 14)) * 5632 + ch + 4 * n; *(f32x4*)p = acc[1][0][3][n]; *(f32x4*)(p + 2816) = acc[1][1][3][n]; } }
#pragma unroll
        for (int n = 0; n < 2; ++n) {
            asm volatile("" ::: "memory");
            f32x4 wv[2][4];
#pragma unroll
            for (int bj = 0; bj < 2; ++bj) {
#pragma unroll
                for (int j = 0; j < 3; ++j) wv[bj][j] = *(const f32x4*)(cw + (size_t)j * 5632 + bj * 2816 + ch + 4 * n);
                wv[bj][3] = *(const f32x4*)(cbias + bj * 2816 + ch + 4 * n); }
#pragma unroll
            for (int ai = 0; ai < 2; ++ai) {
                const int prev = (wr == 1) ? (ai * 2 + 0) : (ai == 1 ? 1 : -1);
                f32x4 vm1[2];
#pragma unroll
                for (int bj = 0; bj < 2; ++bj) { f32x4 z = {0.f, 0.f, 0.f, 0.f};
                    if (prev >= 0 && fr >= 14) z = *(PG8_LAS const f32x4*)(xch + (((prev * 2 + (fr - 14)) * 256) + bj * 128 + c8 + 4 * n) * 4);
                    vm1[bj] = z; }
#pragma unroll
                for (int m = 0; m < 4; ++m) {
                    f32x4 cv[2];
#pragma unroll
                    for (int bj = 0; bj < 2; ++bj) { const f32x4 x = acc[ai][bj][m][n]; const f32x4 xm = (m == 0) ? vm1[bj] : acc[ai][bj][m == 0 ? 0 : m - 1][n];
                        f32x4 r;
#pragma unroll
                        for (int e = 0; e < 4; ++e) { const float a1 = dpp_ror1(x[e]), b1 = dpp_ror1(xm[e]), a2 = dpp_ror2(x[e]), b2 = dpp_ror2(xm[e]);
                            const float p1 = (fr == 0) ? b1 : a1, p2 = (fr < 2) ? b2 : a2;
                            r[e] = wv[bj][3][e] + wv[bj][2][e] * x[e] + wv[bj][1][e] * p1 + wv[bj][0][e] * p2; }
                        cv[bj] = r; }
                    float o[4];
#pragma unroll
                    for (int e = 0; e < 4; ++e) { const float g = cv[0][e]; o[e] = g * __builtin_amdgcn_rcpf(1.f + __expf(-g)) * cv[1][e]; }
                    u32x2 w; w.x = cvt_pk_bf16(o[0], o[1]); w.y = cvt_pk_bf16(o[2], o[3]);
                    const int row = u.pm * BM + ai * HALF + wr * 64 + m * 16 + fr;
                    *(u32x2*)(Act + (size_t)row * 2816 + ch + 4 * n) = w;
                }
            }
        }
    }
};
template <bool LN> struct EpiRes {
    static constexpr bool PERM = false, AFTER_DRAIN = false;
    const float* resid; float* out; const float* stats; const float* g; const float* bta; float alpha; int pad_;
    __device__ __forceinline__ void operator()(const f32x4 (&acc)[2][2][4][2], const Unit& u, int wr, int wc, int fr, int fq) const {
        typedef float f32x2v __attribute__((ext_vector_type(2)));
        const int row0 = u.pm * BM + wr * 64 + fr, col0 = u.pn * BM + wc * 32 + 4 * fq;
#pragma unroll
        for (int bj = 0; bj < 2; ++bj)
#pragma unroll
            for (int n = 0; n < 2; ++n) {
                f32x4 gv, bv;
                if constexpr (LN) { gv = *(const f32x4*)(g + col0 + bj * HALF + n * 16) * alpha; bv = *(const f32x4*)(bta + col0 + bj * HALF + n * 16) * alpha; }
                else { gv = (f32x4){alpha, alpha, alpha, alpha}; bv = (f32x4){0.f, 0.f, 0.f, 0.f}; }
#pragma unroll
                for (int ai = 0; ai < 2; ++ai)
#pragma unroll
                    for (int m = 0; m < 4; ++m) { const int row = row0 + ai * HALF + m * 16; const size_t o = (size_t)row * 1024 + col0 + bj * HALF + n * 16;
                        f32x4 r = *(const f32x4*)(resid + o);
                        if constexpr (LN) { const f32x2v sr = *(const f32x2v*)(stats + 2 * row); r = (r - sr.x) * sr.y; }
                        *(f32x4*)(out + o) = r * gv + bv + acc[ai][bj][m][n]; } }
    }
};
template <class Epi, class Sched, bool ALIGN_EPI = false, bool SP2 = false>
__device__ __forceinline__ void gemm_phase(PG8_LAS unsigned char* lds, const Gemm g, const Sched& S, const Epi& E) {
    const int tid = tid_(), wid = __builtin_amdgcn_readfirstlane(tid >> 6), lane = tid & 63, wr = wid >> 2, wc = wid & 3, fr = lane & 15, fq = lane >> 4;
    const int K = g.K, nt = K / BK;
    unsigned voffA[2], voffB[2];
#pragma unroll
    for (int i = 0; i < 2; ++i) { int R, C; stage_rc(tid * 16 + i * 8192, R, C); const int Rb = Epi::PERM ? ((R & ~31) + perm32(R & 31)) : R;
        voffA[i] = (unsigned)(R * g.lda + C) * 2u; voffB[i] = (unsigned)(Rb * K + C) * 2u; }
    const size_t kstep = (size_t)(BK * 2);
    const size_t hstepA = (size_t)HALF * g.lda * 2, hstepB = (size_t)HALF * K * 2;
    const size_t tstepA = 2 * hstepA, tstepB = 2 * hstepB;
    const unsigned ldsw = (unsigned)wid * 1024u;
    const int aoff = lds_byte(wr * 64 + fr, fq * 8), boff = lds_byte(wc * 32 + fr, fq * 8);
#define PG8_SA(b, h) (((b) * 2 + (h)) * HTB)
#define PG8_SB(b, h) ((4 + (b) * 2 + (h)) * HTB)
#define PG8_STAGE(bufoff, gbase, voff) do { _Pragma("unroll") for (int _i = 0; _i < 2; ++_i) \
        __builtin_amdgcn_global_load_lds((const unsigned*)((const char*)(gbase) + (voff)[_i]), (PG8_LAS unsigned*)(lds + (bufoff) + ldsw + _i * 8192), 16, 0, 0); } while (0)
#define PG8_LDA(dst, b, h) do { _Pragma("unroll") for (int m = 0; m < 4; ++m) _Pragma("unroll") for (int k = 0; k < 2; ++k) dst[m][k] = *(const PG8_LAS bf16x8*)(lds + PG8_SA(b, h) + aoff + m * 2048 + k * 1024); } while (0)
#define PG8_LDB(dst, b, h) do { _Pragma("unroll") for (int n = 0; n < 2; ++n) _Pragma("unroll") for (int k = 0; k < 2; ++k) dst[n][k] = *(const PG8_LAS bf16x8*)(lds + PG8_SB(b, h) + boff + n * 2048 + k * 1024); } while (0)
#define PG8_MMA(ai, bj, At, Bt) do { __builtin_amdgcn_s_setprio(1); _Pragma("unroll") for (int m = 0; m < 4; ++m) _Pragma("unroll") for (int n = 0; n < 2; ++n) _Pragma("unroll") for (int k = 0; k < 2; ++k) \
        acc[ai][bj][m][n] = __builtin_amdgcn_mfma_f32_16x16x32_bf16(Bt[n][k], At[m][k], acc[ai][bj][m][n], 0, 0, 0); __builtin_amdgcn_s_setprio(0); } while (0)
#define PG8_WAIT_V(n) asm volatile("s_waitcnt vmcnt(" #n ")" ::: "memory")
#define PG8_WAIT_L(n) asm volatile("s_waitcnt lgkmcnt(" #n ")" ::: "memory")
#define PG8_BAR __builtin_amdgcn_s_barrier()
#define PG8_SCHED __builtin_amdgcn_sched_barrier(0)
    Unit cur, nxt; int ui = 0;
    if (!S.next(0, cur)) return;
    f32x4 acc[2][2][4][2];
#pragma unroll
    for (int a = 0; a < 2; ++a)
#pragma unroll
        for (int b = 0; b < 2; ++b)
#pragma unroll
            for (int m = 0; m < 4; ++m)
#pragma unroll
                for (int n = 0; n < 2; ++n) acc[a][b][m][n] = (f32x4){0.f, 0.f, 0.f, 0.f};
    bf16x8 At[4][2], B0[2][2], B1[2][2];
    const char* cA = (const char*)g.A + (size_t)cur.pm * tstepA; const char* cB = (const char*)g.Bt + (size_t)cur.pn * tstepB;
    S.a_ready(cur);
    if constexpr (SP2) {
        PG8_STAGE(PG8_SB(0, 0), cB, voffB); PG8_STAGE(PG8_SB(0, 1), cB + hstepB, voffB); PG8_STAGE(PG8_SA(0, 0), cA, voffA); PG8_STAGE(PG8_SA(0, 1), cA + hstepA, voffA);
        if (wr == 1) PG8_BAR;
        PG8_WAIT_V(2); PG8_BAR;
        PG8_STAGE(PG8_SB(1, 0), cB + kstep, voffB); PG8_STAGE(PG8_SA(1, 0), cA + kstep, voffA); PG8_STAGE(PG8_SB(1, 1), cB + hstepB + kstep, voffB);
        PG8_WAIT_V(6); PG8_BAR;
    } else {
        PG8_STAGE(PG8_SB(0, 0), cB, voffB); PG8_STAGE(PG8_SA(0, 0), cA, voffA); PG8_STAGE(PG8_SB(0, 1), cB + hstepB, voffB); PG8_STAGE(PG8_SA(0, 1), cA + hstepA, voffA);
        if (wr == 1) PG8_BAR;
        PG8_WAIT_V(4); PG8_BAR;
        PG8_STAGE(PG8_SB(1, 0), cB + kstep, voffB); PG8_STAGE(PG8_SA(1, 0), cA + kstep, voffA); PG8_STAGE(PG8_SB(1, 1), cB + hstepB + kstep, voffB);
        PG8_WAIT_V(6); PG8_BAR;
    }
    for (;;) {
        const bool has_next = S.next(ui + 1, nxt);
        const char* nA = has_next ? (const char*)g.A + (size_t)nxt.pm * tstepA : cA; const char* nB = has_next ? (const char*)g.Bt + (size_t)nxt.pn * tstepB : cB;
        for (int t = 0; t < nt; t += 2) {
            const bool last = (t == nt - 2);
            const char* a1 = cA + (size_t)(t + 1) * kstep;
            const char* a2 = last ? nA : cA + (size_t)(t + 2) * kstep; const char* b2 = last ? nB : cB + (size_t)(t + 2) * kstep;
            const char* a3 = a2 + kstep; const char* b3 = b2 + kstep;
            if (last && has_next) S.a_ready(nxt);
            if constexpr (SP2) {
            PG8_LDB(B0, 0, 0); PG8_LDB(B1, 0, 1); PG8_SCHED; PG8_LDA(At, 0, 0); PG8_STAGE(PG8_SA(1, 1), a1 + hstepA, voffA);
            PG8_WAIT_V(8); PG8_WAIT_L(0); PG8_BAR; PG8_MMA(0, 0, At, B0); PG8_MMA(0, 1, At, B1); PG8_BAR; PG8_SCHED;
            PG8_LDA(At, 0, 1); PG8_STAGE(PG8_SB(0, 0), b2, voffB); PG8_STAGE(PG8_SB(0, 1), b2 + hstepB, voffB); PG8_STAGE(PG8_SA(0, 0), a2, voffA);
            PG8_WAIT_V(8); PG8_WAIT_L(0); PG8_BAR; PG8_MMA(1, 0, At, B0); PG8_MMA(1, 1, At, B1); PG8_BAR; PG8_SCHED;
            PG8_LDB(B0, 1, 0); PG8_LDB(B1, 1, 1); PG8_SCHED; PG8_LDA(At, 1, 0); PG8_STAGE(PG8_SA(0, 1), a2 + hstepA, voffA);
            PG8_WAIT_V(8); PG8_WAIT_L(0); PG8_BAR; PG8_MMA(0, 0, At, B0); PG8_MMA(0, 1, At, B1); PG8_BAR; PG8_SCHED;
            PG8_LDA(At, 1, 1); PG8_STAGE(PG8_SB(1, 0), b3, voffB); PG8_STAGE(PG8_SB(1, 1), b3 + hstepB, voffB); PG8_STAGE(PG8_SA(1, 0), a3, voffA);
            PG8_WAIT_V(8); PG8_WAIT_L(0); PG8_BAR; PG8_MMA(1, 0, At, B0); PG8_MMA(1, 1, At, B1); PG8_BAR; PG8_SCHED;
            } else {
            PG8_LDB(B0, 0, 0); PG8_SCHED; PG8_LDA(At, 0, 0); PG8_STAGE(PG8_SA(1, 1), a1 + hstepA, voffA);
            PG8_WAIT_L(8); PG8_BAR; PG8_WAIT_L(0); PG8_MMA(0, 0, At, B0); PG8_BAR; PG8_SCHED;
            PG8_LDB(B1, 0, 1); PG8_STAGE(PG8_SB(0, 0), b2, voffB);
            PG8_BAR; PG8_WAIT_L(0); PG8_MMA(0, 1, At, B1); PG8_BAR;
            PG8_LDA(At, 0, 1); PG8_STAGE(PG8_SA(0, 0), a2, voffA);
            PG8_BAR; PG8_WAIT_L(0); PG8_MMA(1, 0, At, B0); PG8_BAR; PG8_SCHED;
            PG8_STAGE(PG8_SB(0, 1), b2 + hstepB, voffB);
            PG8_WAIT_V(6); PG8_BAR; PG8_MMA(1, 1, At, B1); PG8_BAR;
            PG8_LDB(B0, 1, 0); PG8_SCHED; PG8_LDA(At, 1, 0); PG8_STAGE(PG8_SA(0, 1), a2 + hstepA, voffA);
            PG8_WAIT_L(8); PG8_BAR; PG8_WAIT_L(0); PG8_MMA(0, 0, At, B0); PG8_BAR; PG8_SCHED;
            PG8_LDB(B1, 1, 1); PG8_STAGE(PG8_SB(1, 0), b3, voffB);
            PG8_BAR; PG8_WAIT_L(0); PG8_MMA(0, 1, At, B1); PG8_BAR;
            PG8_LDA(At, 1, 1); PG8_STAGE(PG8_SA(1, 0), a3, voffA);
            PG8_BAR; PG8_WAIT_L(0); PG8_MMA(1, 0, At, B0); PG8_BAR; PG8_SCHED;
            PG8_STAGE(PG8_SB(1, 1), b3 + hstepB, voffB);
            PG8_WAIT_V(6); PG8_BAR; PG8_MMA(1, 1, At, B1); PG8_BAR;
            }
        }
        if constexpr (ALIGN_EPI) { if (wr == 0) PG8_BAR; }
        if constexpr (!Epi::AFTER_DRAIN) { E(acc, cur, wr, wc, fr, fq); S.done(cur); }
        if (!has_next) break;
#pragma unroll
        for (int a = 0; a < 2; ++a)
#pragma unroll
            for (int b = 0; b < 2; ++b)
#pragma unroll
                for (int m = 0; m < 4; ++m)
#pragma unroll
                    for (int n = 0; n < 2; ++n) acc[a][b][m][n] = (f32x4){0.f, 0.f, 0.f, 0.f};
        cur = nxt; cA = nA; cB = nB; ++ui;
        if constexpr (ALIGN_EPI) { if (wr == 1) PG8_BAR; }
    }
    PG8_WAIT_V(0);
    if constexpr (!ALIGN_EPI) { if (wr == 0) PG8_BAR; }
    PG8_BAR;
    if constexpr (Epi::AFTER_DRAIN) { E.fused(acc, cur, wr, wc, fr, fq, lds, wid, lane); S.done(cur); }
#undef PG8_SA
#undef PG8_SB
#undef PG8_STAGE
#undef PG8_LDA
#undef PG8_LDB
#undef PG8_MMA
#undef PG8_WAIT_V
#undef PG8_WAIT_L
#undef PG8_BAR
#undef PG8_SCHED
}
}
#define LAS __attribute__((address_space(3)))
#define DI __device__ __forceinline__
typedef unsigned short bf16;
typedef short bf16x8 __attribute__((ext_vector_type(8)));
typedef short s16x4 __attribute__((ext_vector_type(4)));
typedef float f32x4 __attribute__((ext_vector_type(4)));
typedef float f32x16 __attribute__((ext_vector_type(16)));
typedef unsigned u32x4 __attribute__((ext_vector_type(4)));
typedef unsigned u32x2 __attribute__((ext_vector_type(2)));
#define LDS_WAIT() asm volatile("s_waitcnt lgkmcnt(0)" ::: "memory")
#define MFMA32(a, b, c) __builtin_amdgcn_mfma_f32_32x32x16_bf16((a), (b), (c), 0, 0, 0)
#define LBAR() do { asm volatile("s_waitcnt lgkmcnt(0)" ::: "memory"); __builtin_amdgcn_s_barrier(); asm volatile("" ::: "memory"); } while (0)

constexpr int T = 16384, D = 1024, SEQ = 2048, NB = 8, TM = 2048;
constexpr int DFF = 2816, DFH = 1408;
constexpr float ALPHA = 1.4142135623730951f;
constexpr float LOG2E = 1.4426950408889634f;
constexpr size_t MiB = 1u << 20;
constexpr size_t WS_ROPE = 0;
constexpr size_t WS_G16 = 1 * MiB;
constexpr size_t WS_HALO = 2 * MiB;
constexpr size_t WS_MEMB = 7 * MiB;
constexpr size_t WS_KVM = 11 * MiB;
constexpr size_t WS_WIN = 19 * MiB;
constexpr size_t WS_WOUT = 28 * MiB, WS_WQ = 30 * MiB, WS_WKV = 32 * MiB, WS_WO = 36 * MiB, WS_WFI = 38 * MiB, WS_WFOA = 49 * MiB, WS_WFOB = 52 * MiB;
constexpr size_t WS_HB = 56 * MiB;
constexpr size_t WS_BIG = 88 * MiB;
constexpr size_t WS_ACT = 176 * MiB;
constexpr size_t WS_WKV1 = 240 * MiB;
constexpr int LDS_BYTES = 147456;

DI unsigned cvtpk(float lo, float hi) { return pg8::cvt_pk_bf16(lo, hi); }
DI bf16 f2bf(float f) { return (bf16)(cvtpk(f, 0.f) & 0xffffu); }
DI float bf2f(bf16 v) { return __uint_as_float(((unsigned)v) << 16); }
DI float bflo(unsigned w) { return __uint_as_float(w << 16); }
DI float bfhi(unsigned w) { return __uint_as_float(w & 0xffff0000u); }
DI int crow(int i, int h) { return (i & 3) + 8 * (i >> 2) + 4 * h; }
DI int kperm(int key) { return (key & ~12) | ((key & 4) << 1) | ((key & 8) >> 1); }
DI float wave_sum(float v) {
#pragma unroll
    for (int o = 1; o < 64; o <<= 1) v += __shfl_xor(v, o);
    return v;
}
DI float siluf(float x) { return x * __builtin_amdgcn_rcpf(1.f + __expf(-x)); }
DI float sigmoidf_(float x) { return __builtin_amdgcn_rcpf(1.f + __expf(-x)); }
DI bf16x8 pack8(const f32x16& x, int s) { u32x4 p; p.x = cvtpk(x[8 * s], x[8 * s + 1]); p.y = cvtpk(x[8 * s + 2], x[8 * s + 3]); p.z = cvtpk(x[8 * s + 4], x[8 * s + 5]); p.w = cvtpk(x[8 * s + 6], x[8 * s + 7]); return __builtin_bit_cast(bf16x8, p); }
DI bf16x8 lds_rd16(LAS const unsigned char* p) { return *(LAS const bf16x8*)p; }
DI bf16x8 lds_rd8x2(LAS const unsigned char* p) { const s16x4 lo = *(LAS const s16x4*)p, hi = *(LAS const s16x4*)(p + 16); return __builtin_shufflevector(lo, hi, 0, 1, 2, 3, 4, 5, 6, 7); }
DI void unpack8(const u32x4 w, float* f) { f[0] = bflo(w.x); f[1] = bfhi(w.x); f[2] = bflo(w.y); f[3] = bfhi(w.y); f[4] = bflo(w.z); f[5] = bfhi(w.z); f[6] = bflo(w.w); f[7] = bfhi(w.w); }
DI u32x4 packf8(const float* f) { u32x4 w; w.x = cvtpk(f[0], f[1]); w.y = cvtpk(f[2], f[3]); w.z = cvtpk(f[4], f[5]); w.w = cvtpk(f[6], f[7]); return w; }
DI void st16_wt(void* p, u32x4 v) { asm volatile("global_store_dwordx4 %0, %1, off sc1\n\ts_nop 1" :: "v"(p), "v"(v) : "memory"); }
DI void zero16(f32x16& a) {
#pragma unroll
    for (int i = 0; i < 16; ++i) a[i] = 0.f;
}

#define XB_TMO      128
#define XB_XCNT(j)  (256  + 64 * (j))
#define XB_XSUB(j)  (1280 + 64 * (j))
#define XB_XGEN(j)  (2304 + 64 * (j))
#define XB_TOP      3328
#define XB_TOPGEN   3392
#define XCD_BAR_WORDS 3456
#define XB_SPIN_CAP (1u << 18)

__device__ __forceinline__ unsigned xb_ld(unsigned* p)              { return __hip_atomic_load(p, __ATOMIC_RELAXED, __HIP_MEMORY_SCOPE_AGENT); }
__device__ __forceinline__ unsigned xb_add(unsigned* p, unsigned v) { return __hip_atomic_fetch_add(p, v, __ATOMIC_RELAXED, __HIP_MEMORY_SCOPE_AGENT); }
__device__ __forceinline__ unsigned xb_xcc_id() { return (unsigned)__builtin_amdgcn_s_getreg((3 << 11) | 20) & 0xFu; }
#define XB_SPIN(cond, bar) do { unsigned _sp = 0; while (cond) { __builtin_amdgcn_s_sleep(1); \
    if ((++_sp & 255u) == 0u) { if (xb_ld(&(bar)[XB_TMO])) break; if (_sp > XB_SPIN_CAP) { atomicAdd(&(bar)[XB_TMO], 1u); break; } } } } while (0)

struct XcdBarrier {
    unsigned* bar; unsigned x;
    volatile LAS unsigned* st;
};

__device__ __forceinline__ XcdBarrier xcd_barrier_post(unsigned* bar, volatile LAS unsigned* st) {
    XcdBarrier b; b.bar = bar; b.x = xb_xcc_id(); b.st = st;
    if (threadIdx.x == 0) (void)xb_add(&bar[XB_XCNT(b.x)], 1u);
    return b;
}
__device__ __forceinline__ void xcd_barrier_complete(unsigned* bar, unsigned x, unsigned& nloc, unsigned& nx) {
    const unsigned G = gridDim.x * gridDim.y * gridDim.z;
    unsigned sum, cnt, mine, sp = 0u;
    for (;;) {
        sum = 0u; cnt = 0u; mine = 0u;
#pragma unroll
        for (unsigned j = 0; j < 16; ++j) { const unsigned c = xb_ld(&bar[XB_XCNT(j)]); sum += c; cnt += (c > 0u) ? 1u : 0u; mine = (j == x) ? c : mine; }
        if (sum == G) break;
        __builtin_amdgcn_s_sleep(1);
        if ((++sp & 255u) == 0u) { if (xb_ld(&bar[XB_TMO])) break; if (sp > XB_SPIN_CAP) { atomicAdd(&bar[XB_TMO], 1u); break; } }
    }
    nloc = mine > 0u ? mine : 1u; nx = cnt > 0u ? cnt : 1u;
}

__device__ __forceinline__ void xcd_barrier(const XcdBarrier& b) {
    asm volatile("s_waitcnt vmcnt(0)" ::: "memory");
    __syncthreads();
    if (threadIdx.x == 0) {
        unsigned* bar = b.bar;
        __builtin_amdgcn_s_waitcnt(0);
        unsigned nloc = b.st[0], nx = b.st[1];
        if (nloc == 0u) { xcd_barrier_complete(bar, b.x, nloc, nx); b.st[0] = nloc; b.st[1] = nx; }
        const unsigned old = xb_add(&bar[XB_XSUB(b.x)], 1u);
        const unsigned gen = old / nloc;
        if (old + 1u == (gen + 1u) * nloc) {
            __builtin_amdgcn_fence(__ATOMIC_RELEASE, "agent");
            asm volatile("s_waitcnt vmcnt(0)" ::: "memory");
            const unsigned og = xb_add(&bar[XB_TOP], 1u);
            const unsigned tg = og / nx;
            if (og + 1u == (tg + 1u) * nx) xb_add(&bar[XB_TOPGEN], 1u);
            else XB_SPIN(xb_ld(&bar[XB_TOPGEN]) == tg, bar);
            __builtin_amdgcn_fence(__ATOMIC_ACQUIRE, "agent");
            xb_add(&bar[XB_XGEN(b.x)], 1u);
            asm volatile("s_waitcnt vmcnt(0)" ::: "memory");
        } else {
            XB_SPIN(xb_ld(&bar[XB_XGEN(b.x)]) == gen, bar);
            __builtin_amdgcn_fence(__ATOMIC_ACQUIRE, "agent");
            asm volatile("s_waitcnt vmcnt(0)" ::: "memory");
        }
    }
    __syncthreads();
}
constexpr size_t WS_BAR = 55 * MiB;
struct Args { const float* in[42]; float* out; unsigned char* ws; int ph_lo, ph_hi; };
#if defined(__HIP_DEVICE_COMPILE__)
DI const float* inptr(int i) { const void* p = (const void*)__builtin_amdgcn_kernarg_segment_ptr(); asm volatile("" : "+s"(p)); return ((const float* const*)p)[i]; }
#else
DI const float* inptr(int) { return nullptr; }
#endif

DI void transpose_item(const float* W, int ldw, bf16* WT, int ldt, int k0, int n0, int drow0, int dk0, LAS float* scr, int lane) {
    float tv[32];
#pragma unroll
    for (int i = 0; i < 32; ++i) { const int kk = 2 * i + (lane >> 5); tv[i] = W[(size_t)(k0 + kk) * ldw + n0 + (lane & 31)]; }
#pragma unroll
    for (int i = 0; i < 32; ++i) { const int kk = 2 * i + (lane >> 5); scr[kk * 33 + (lane & 31)] = tv[i]; }
    LDS_WAIT();
    const int c = lane & 7;
#pragma unroll
    for (int j = 0; j < 4; ++j) { const int n = (lane >> 3) + 8 * j; const LAS float* s = scr + (8 * c) * 33 + n;
        u32x4 o; o.x = cvtpk(s[0 * 33], s[1 * 33]); o.y = cvtpk(s[2 * 33], s[3 * 33]); o.z = cvtpk(s[4 * 33], s[5 * 33]); o.w = cvtpk(s[6 * 33], s[7 * 33]);
        *(u32x4*)(WT + (size_t)(drow0 + n) * ldt + dk0 + 8 * c) = o; }
    LDS_WAIT();
}
DI void convert_weights(const Args& a, int layer, LAS unsigned char* lds, int gw, int NGW, int wave, int lane) {
    unsigned char* ws = a.ws;
    const int cb = layer ? 29 : 10;
    const float* w_in = inptr(layer ? 23 : 3); const int nin = layer ? 4112 : 3088, nmain = layer ? 4096 : 3072;
    const float* w_out = inptr(layer ? 28 : 9);
    const float *wq = inptr(cb + 2), *wkv = inptr(cb + 3), *wo = inptr(cb + 4), *fin = inptr(cb + 7), *fout = inptr(cb + 10);
    LAS float* scr = (LAS float*)(lds + wave * 16384);
    const int I_IN = 16 * (nmain / 32), I_SQ = 16 * 32, I_KV = 16 * 64, I_FI = 16 * 176, I_FO = 44 * 32;
    const int NITEMS = I_IN + 3 * I_SQ + I_KV + I_FI + I_FO;
    for (int it = gw; it < NITEMS; it += NGW) {
        int r = it;
        if (r < I_IN) { const int nb = nmain / 32, kb = r / nb, n0 = 32 * (r % nb); transpose_item(w_in, nin, (bf16*)(ws + WS_WIN), 1024, 64 * kb, n0, n0, 64 * kb, scr, lane); continue; } r -= I_IN;
        if (r < I_SQ) { const int kb = r / 32, n0 = 32 * (r % 32); transpose_item(w_out, 1024, (bf16*)(ws + WS_WOUT), 1024, 64 * kb, n0, n0, 64 * kb, scr, lane); continue; } r -= I_SQ;
        if (r < I_SQ) { const int kb = r / 32, n0 = 32 * (r % 32); transpose_item(wq, 1024, (bf16*)(ws + WS_WQ), 1024, 64 * kb, n0, n0, 64 * kb, scr, lane); continue; } r -= I_SQ;
        if (r < I_SQ) { const int kb = r / 32, n0 = 32 * (r % 32); transpose_item(wo, 1024, (bf16*)(ws + WS_WO), 1024, 64 * kb, n0, n0, 64 * kb, scr, lane); continue; } r -= I_SQ;
        if (r < I_KV) { const int kb = r / 64, n0 = 32 * (r % 64); transpose_item(wkv, 2048, (bf16*)(ws + WS_WKV), 1024, 64 * kb, n0, n0, 64 * kb, scr, lane); continue; } r -= I_KV;
        if (r < I_FI) { const int kb = r / 176, n0 = 32 * (r % 176); const int half = n0 / DFF, c = n0 % DFF; const int drow = (c / 128) * 256 + half * 128 + (c % 128);
            transpose_item(fin, 2 * DFF, (bf16*)(ws + WS_WFI), 1024, 64 * kb, n0, drow, 64 * kb, scr, lane); continue; } r -= I_FI;
        { const int kb = r / 32, n0 = 32 * (r % 32); const int k0 = 64 * kb;
          transpose_item(fout, 1024, (bf16*)(ws + WS_WFOA), DFF, k0, n0, n0, k0, scr, lane); }
    }
    bf16* wt = (bf16*)(ws + WS_WIN);
    for (int idx = gw * 64 + lane; idx < 16 * 1024; idx += NGW * 64) { const int j = idx & 15, k = idx >> 4; wt[(size_t)(nmain + j) * 1024 + k] = f2bf(w_in[(size_t)k * nin + nmain + j]); }
}
DI void to_bf16(const float* src, bf16* dst, size_t n, int gtid, int gthreads) {
    for (size_t i = (size_t)gtid * 8; i < n; i += (size_t)gthreads * 8) { const f32x4 a = *(const f32x4*)(src + i), b = *(const f32x4*)(src + i + 4);
        u32x4 o; o.x = cvtpk(a[0], a[1]); o.y = cvtpk(a[2], a[3]); o.z = cvtpk(b[0], b[1]); o.w = cvtpk(b[2], b[3]); *(u32x4*)(dst + i) = o; }
}
DI void rope_table(const int* pos, float* tab, int gtid, int gthreads) {
    for (int i = gtid; i < T * 8; i += gthreads) { const int t = i >> 3, f = i & 7;
        const float inv = exp2f(-(float)f * (18.931568569324174f / 8.f));
        const double ang = (double)((float)pos[t] * inv);
        double r = ang * 0.15915494309189535; r -= floor(r);
        const float rf = (float)r;
        tab[(size_t)t * 16 + f] = __builtin_amdgcn_cosf(rf); tab[(size_t)t * 16 + 8 + f] = __builtin_amdgcn_sinf(rf); }
}
DI void ln_apply(const float* y, const float* g, const float* bta, float* outf, bf16* outb, float* stats, int gw, int NGW, int lane) {
    f32x4 gv[4], bv[4];
#pragma unroll
    for (int j = 0; j < 4; ++j) { gv[j] = ((const f32x4*)g)[lane + 64 * j]; bv[j] = ((const f32x4*)bta)[lane + 64 * j]; }
    const bool xl = (NGW == 2048); const int blk_ = gw >> 3, wv_ = gw & 7;
    const int mbeg = xl ? (blk_ & 7) * 2048 + ((blk_ >> 3) * 8 + wv_) * 8 : 2 * gw, mend = xl ? mbeg + 8 : T, mstep = xl ? 2 : 2 * NGW;
    for (int m0 = mbeg; m0 < mend; m0 += mstep) {
        f32x4 v[2][4]; float s[2] = {0.f, 0.f};
#pragma unroll
        for (int r = 0; r < 2; ++r) { const f32x4* xr = (const f32x4*)(y + (size_t)(m0 + r) * D) + lane;
#pragma unroll
            for (int j = 0; j < 4; ++j) v[r][j] = xr[64 * j]; }
#pragma unroll
        for (int r = 0; r < 2; ++r) {
#pragma unroll
            for (int j = 0; j < 4; ++j) s[r] += (v[r][j][0] + v[r][j][1]) + (v[r][j][2] + v[r][j][3]);
            const float mean = wave_sum(s[r]) * (1.f / D); float s2 = 0.f;
#pragma unroll
            for (int j = 0; j < 4; ++j) { v[r][j] = v[r][j] - mean; s2 += (v[r][j][0] * v[r][j][0] + v[r][j][1] * v[r][j][1]) + (v[r][j][2] * v[r][j][2] + v[r][j][3] * v[r][j][3]); }
            const float rstd = 1.f / sqrtf(wave_sum(s2) * (1.f / D) + 1e-5f);
            const size_t m = m0 + r;
            if (stats && lane == 0) { stats[2 * m] = mean; stats[2 * m + 1] = rstd; }
#pragma unroll
            for (int j = 0; j < 4; ++j) { const f32x4 o = v[r][j] * rstd * gv[j] + bv[j];
                if (!stats) ((f32x4*)(outf + m * D))[lane + 64 * j] = o;
                if (outb) { u32x2 w; w.x = cvtpk(o[0], o[1]); w.y = cvtpk(o[2], o[3]); ((u32x2*)(outb + m * D))[lane + 64 * j] = w; } }
        }
    }
}
DI bool so_next(const pg8::StaticOrder& S, int i, int& pm, int& pn) {
    const long Lx = (long)i * S.G + S.c; if (Lx >= S.nwg) return false;
    int wgid = (int)Lx; { const int q = S.nwg / pg8::NXCD, r = S.nwg % pg8::NXCD, xcd = wgid % pg8::NXCD, off = wgid / pg8::NXCD; wgid = (xcd < r ? xcd * (q + 1) : r * (q + 1) + (xcd - r) * q) + off; }
    const int nig = pg8::WGM * S.nN, gid = wgid / nig, fm = gid * pg8::WGM, gsz = (S.nM - fm) < pg8::WGM ? (S.nM - fm) : pg8::WGM;
    pm = fm + ((wgid % nig) % gsz); pn = (wgid % nig) / gsz; return true;
}
DI void ffn_fix(const float* RAW, bf16* Act, const float* cw, const float* cbias, int pm, int tid) {
    if ((pm & 7) == 0) return;
    for (int rem = tid; rem < 1408; rem += 512) {
        const int j = rem / 704, ch = 4 * (rem % 704);
        const float* x0 = RAW + ((size_t)pm * 4 + j) * 5632;
        const float* x1 = j == 0 ? RAW + ((size_t)(pm - 1) * 4 + 3) * 5632 : RAW + ((size_t)pm * 4 + 0) * 5632;
        const float* x2 = j == 0 ? RAW + ((size_t)(pm - 1) * 4 + 2) * 5632 : RAW + ((size_t)(pm - 1) * 4 + 3) * 5632;
        f32x4 cv[2];
#pragma unroll
        for (int bj = 0; bj < 2; ++bj) { const int col = bj * 2816 + ch;
            cv[bj] = *(const f32x4*)(cbias + col) + *(const f32x4*)(cw + 2 * 5632 + col) * *(const f32x4*)(x0 + col) + *(const f32x4*)(cw + 5632 + col) * *(const f32x4*)(x1 + col) + *(const f32x4*)(cw + col) * *(const f32x4*)(x2 + col); }
        u32x2 w; w.x = cvtpk(siluf(cv[0][0]) * cv[1][0], siluf(cv[0][1]) * cv[1][1]); w.y = cvtpk(siluf(cv[0][2]) * cv[1][2], siluf(cv[0][3]) * cv[1][3]);
        *(u32x2*)(Act + (size_t)(pm * 256 + j) * 2816 + ch) = w;
    }
}
DI void gate_cols(const bf16* A, const bf16* Wg, float* G16, int task) {
    const int lane = tid_() & 63, l31 = lane & 31, h = lane >> 5;
    const bf16* ap = A + (size_t)(32 * task + l31) * 1024 + 8 * h; const bf16* bp = Wg + (size_t)(l31 & 15) * 1024 + 8 * h;
    f32x16 c; zero16(c);
#pragma unroll 16
    for (int ks = 0; ks < 64; ++ks) { const bf16x8 a = *(const bf16x8*)(ap + 16 * ks); bf16x8 bb = *(const bf16x8*)(bp + 16 * ks);
        if (l31 >= 16) bb = (bf16x8){0, 0, 0, 0, 0, 0, 0, 0};
        c = MFMA32(a, bb, c); }
    if (l31 < 16) {
#pragma unroll
        for (int i = 0; i < 16; ++i) G16[(size_t)(32 * task + crow(i, h)) * 16 + l31] = c[i]; }
}
constexpr int DA_KS = 272, DA_VT = 176;
constexpr int DA_OFF_K = 0, DA_OFF_V = 64 * DA_KS, DA_OFF_C = DA_OFF_V + 128 * DA_VT;
DI void diffattn_unit(const bf16* Hin, const float* rope, const float* gnorm, bf16* Omix, LAS unsigned char* L, int b, int hh, int qb, float lam) {
    const int tid = tid_(), wave = __builtin_amdgcn_readfirstlane(tid >> 6), lane = tid & 63, l31 = lane & 31, h = lane >> 5;
    const int map = wave >> 2, wq = wave & 3;
    const int q0 = qb * 128 + wq * 32;
    const size_t tq = (size_t)b * SEQ + q0 + l31;
    bf16x8 qf[4];
    { const bf16* qrow = Hin + tq * 3072 + hh * 128 + map * 64;
#pragma unroll
      for (int ks = 1; ks < 4; ++ks) qf[ks] = *(const bf16x8*)(qrow + 16 * ks + 8 * h);
      float x1[8], x2[8], o[8]; unpack8(*(const u32x4*)qrow, x1); unpack8(*(const u32x4*)(qrow + 8), x2);
      const float* rt = rope + tq * 16;
#pragma unroll
      for (int j = 0; j < 8; ++j) { const float c = rt[j], s = rt[8 + j]; o[j] = h == 0 ? x1[j] * c - x2[j] * s : x2[j] * c + x1[j] * s; }
      qf[0] = __builtin_bit_cast(bf16x8, packf8(o)); }
    f32x16 o[4];
#pragma unroll
    for (int i = 0; i < 4; ++i) zero16(o[i]);
    float mrun = -INFINITY, lrun = 0.f;
    const float sc = 0.125f * LOG2E;
    const int kend = qb * 128 + 128;
    u32x4 pk[2], pp[2], pv[2]; f32x4 prc[2][2], prs[2][2];
#define DA_LOAD(kk) do { _Pragma("unroll") for (int i = 0; i < 2; ++i) { const int c = tid + 512 * i, key = c & 63, ch = c >> 6; const size_t tk = (size_t)b * SEQ + (kk) + key; \
        const bf16* krow = Hin + tk * 3072 + 512 + hh * 128; pk[i] = *(const u32x4*)(krow + 8 * ch); \
        if ((ch & 7) < 2) { pp[i] = *(const u32x4*)(krow + 8 * (ch ^ 1)); const f32x4* rt = (const f32x4*)(rope + tk * 16); prc[i][0] = rt[0]; prc[i][1] = rt[1]; prs[i][0] = rt[2]; prs[i][1] = rt[3]; } \
        pv[i] = *(const u32x4*)(Hin + tk * 3072 + 1024 + hh * 128 + 8 * ch); } } while (0)
    DA_LOAD(0);
    for (int k0 = 0; k0 < kend; k0 += 64) {
        LBAR();
#pragma unroll
        for (int i = 0; i < 2; ++i) { const int c = tid + 512 * i, key = c & 63, ch = c >> 6;
            u32x4 v = pk[i];
            if ((ch & 7) < 2) { float a[8], p[8], r[8]; unpack8(v, a); unpack8(pp[i], p);
#pragma unroll
                for (int j = 0; j < 8; ++j) { const float cc = prc[i][j >> 2][j & 3], sn = prs[i][j >> 2][j & 3]; r[j] = (ch & 1) == 0 ? a[j] * cc - p[j] * sn : a[j] * cc + p[j] * sn; }
                v = packf8(r); }
            *(LAS u32x4*)(L + DA_OFF_K + key * DA_KS + ch * 16) = v;
            const u32x4 vv = pv[i];
            LAS bf16* vt = (LAS bf16*)(L + DA_OFF_V + (8 * ch) * DA_VT + kperm(key) * 2);
            vt[0 * (DA_VT / 2)] = (bf16)(vv.x & 0xffff); vt[1 * (DA_VT / 2)] = (bf16)(vv.x >> 16); vt[2 * (DA_VT / 2)] = (bf16)(vv.y & 0xffff); vt[3 * (DA_VT / 2)] = (bf16)(vv.y >> 16);
            vt[4 * (DA_VT / 2)] = (bf16)(vv.z & 0xffff); vt[5 * (DA_VT / 2)] = (bf16)(vv.z >> 16); vt[6 * (DA_VT / 2)] = (bf16)(vv.w & 0xffff); vt[7 * (DA_VT / 2)] = (bf16)(vv.w >> 16); }
        LBAR();
        if (k0 + 64 < kend) DA_LOAD(k0 + 64);
        if (k0 <= q0 + 31) {
            f32x16 st[2];
#pragma unroll
            for (int kt = 0; kt < 2; ++kt) { zero16(st[kt]);
#pragma unroll
                for (int ks = 0; ks < 4; ++ks) { const bf16x8 a = lds_rd16(L + DA_OFF_K + (32 * kt + l31) * DA_KS + (map * 64 + 16 * ks + 8 * h) * 2); st[kt] = MFMA32(a, qf[ks], st[kt]); } }
            const bool diag = (k0 + 63 > q0);
            float mx = -INFINITY;
            if (diag) {
#pragma unroll
                for (int kt = 0; kt < 2; ++kt)
#pragma unroll
                    for (int i = 0; i < 16; ++i) { if (k0 + 32 * kt + crow(i, h) > q0 + l31) st[kt][i] = -INFINITY; } }
#pragma unroll
            for (int kt = 0; kt < 2; ++kt)
#pragma unroll
                for (int i = 0; i < 16; ++i) mx = fmaxf(mx, st[kt][i]);
            mx = fmaxf(mx, __shfl_xor(mx, 32));
            const float mnew = fmaxf(mrun, mx), alpha = __builtin_amdgcn_exp2f((mrun - mnew) * sc), nm = -mnew * sc;
            float rs = 0.f;
#pragma unroll
            for (int kt = 0; kt < 2; ++kt)
#pragma unroll
                for (int i = 0; i < 16; ++i) { const float p = __builtin_amdgcn_exp2f(__builtin_fmaf(st[kt][i], sc, nm)); st[kt][i] = p; rs += p; }
            rs += __shfl_xor(rs, 32);
            lrun = lrun * alpha + rs; mrun = mnew;
            if (__ballot(alpha != 1.f) != 0ull) {
#pragma unroll
                for (int mt = 0; mt < 4; ++mt)
#pragma unroll
                    for (int i = 0; i < 16; ++i) o[mt][i] *= alpha; }
#pragma unroll
            for (int kt = 0; kt < 2; ++kt)
#pragma unroll
                for (int s2 = 0; s2 < 2; ++s2) { const bf16x8 pb = pack8(st[kt], s2);
#pragma unroll
                    for (int mt = 0; mt < 4; ++mt) { const bf16x8 a = lds_rd16(L + DA_OFF_V + (32 * mt + l31) * DA_VT + (32 * kt + 16 * s2 + 8 * h) * 2); o[mt] = MFMA32(a, pb, o[mt]); } }
        }
    }
    const float inv = (map == 0 ? 1.f : lam) / lrun;
    LAS float* cbuf = (LAS float*)(L + DA_OFF_C) + wq * 4096 + lane;
    if (map == 1) {
#pragma unroll
        for (int mt = 0; mt < 4; ++mt)
#pragma unroll
            for (int i = 0; i < 16; ++i) cbuf[(mt * 16 + i) * 64] = o[mt][i] * inv;
    }
    __syncthreads();
    if (map == 0) {
        float ss = 0.f;
#pragma unroll
        for (int mt = 0; mt < 4; ++mt)
#pragma unroll
            for (int i = 0; i < 16; ++i) { const float v = o[mt][i] * inv - cbuf[(mt * 16 + i) * 64]; o[mt][i] = v; ss += v * v; }
        ss += __shfl_xor(ss, 32);
        const float r = rsqrtf(ss * (1.f / 128.f) + 1e-6f) * 0.8f;
        bf16* orow = Omix + tq * 1024 + hh * 128;
#pragma unroll
        for (int mt = 0; mt < 4; ++mt)
#pragma unroll
            for (int g4 = 0; g4 < 4; ++g4) { const int dv = 32 * mt + 8 * g4 + 4 * h; const f32x4 gn = *(const f32x4*)(gnorm + dv);
                u32x2 w; w.x = cvtpk(o[mt][4 * g4] * r * gn[0], o[mt][4 * g4 + 1] * r * gn[1]); w.y = cvtpk(o[mt][4 * g4 + 2] * r * gn[2], o[mt][4 * g4 + 3] * r * gn[3]);
                *(u32x2*)(orow + dv) = w; }
    }
}
constexpr int GL_QS = 0, GL_KS = 64 * 144, GL_KH = 2 * 64 * 144, GL_VT = 3 * 64 * 144, GL_ST = GL_VT + 128 * 144, GL_TOT = GL_ST + 128 * 144, GL_BL = GL_TOT + 8 * 64 * 4, GL_SS = GL_BL + 256;
#define GLA_GATES(bl, tot) \
    float bl[8]; float tot = 0.f; { float run = 0.f; \
        _Pragma("unroll") for (int j = 0; j < 8; ++j) { const f32x4* gl = (const f32x4*)(G16 + (t0 + 8 * wave + j) * 16); float x = b2r; \
            _Pragma("unroll") for (int r4 = 0; r4 < 4; ++r4) { const f32x4 gq = gl[r4]; x += gq[0] * w2r[4 * r4] + gq[1] * w2r[4 * r4 + 1] + gq[2] * w2r[4 * r4 + 2] + gq[3] * w2r[4 * r4 + 3]; } \
            const float ls = fminf(x, 0.f) - __logf(1.f + __expf(-fabsf(x))); run += ls * (1.f / 16.f); bl[j] = run; } \
        __syncthreads(); \
        ((LAS float*)(L + GL_TOT))[wave * 64 + lane] = run; \
        __syncthreads(); \
        float pre = 0.f; \
        _Pragma("unroll") for (int w = 0; w < 8; ++w) { const float x = ((LAS float*)(L + GL_TOT))[w * 64 + lane]; tot += x; if (w < wave) pre += x; } \
        _Pragma("unroll") for (int j = 0; j < 8; ++j) bl[j] += pre; }
#define GLA_STAGE_VT() \
    _Pragma("unroll") for (int i = 0; i < 2; ++i) { const int c = tid + 512 * i, key = c & 63, ch = c >> 6; \
        const u32x4 vv = *(const u32x4*)(Hin + (t0 + key) * 3072 + 2048 + hh * 128 + 8 * ch); \
        LAS bf16* vtp = (LAS bf16*)(L + GL_VT + (8 * ch) * 144 + key * 2); \
        vtp[0 * 72] = (bf16)(vv.x & 0xffff); vtp[1 * 72] = (bf16)(vv.x >> 16); vtp[2 * 72] = (bf16)(vv.y & 0xffff); vtp[3 * 72] = (bf16)(vv.y >> 16); \
        vtp[4 * 72] = (bf16)(vv.z & 0xffff); vtp[5 * 72] = (bf16)(vv.z >> 16); vtp[6 * 72] = (bf16)(vv.w & 0xffff); vtp[7 * 72] = (bf16)(vv.w >> 16); }
DI void gla_passA_unit(const bf16* Hin, const float* G16, const float* w2, const float* b2, float* LOC, float* DEC, LAS unsigned char* L, int b, int hh, int n) {
    const int tid = tid_(), wave = __builtin_amdgcn_readfirstlane(tid >> 6), lane = tid & 63, l31 = lane & 31, h = lane >> 5;
    const int vt = wave & 3, tt = wave >> 2;
    float w2r[16];
#pragma unroll
    for (int r = 0; r < 16; ++r) w2r[r] = w2[r * 256 + hh * 64 + lane];
    const float b2r = b2[hh * 64 + lane];
    const size_t t0 = (size_t)b * SEQ + 64 * n;
    const int unit = (b * 4 + hh) * 32 + n;
    GLA_GATES(bl, tot)
    if (wave == 0) DEC[(size_t)unit * 64 + lane] = __expf(tot);
#pragma unroll
    for (int j = 0; j < 8; ++j) { const int t = 8 * wave + j;
        const float kv = bf2f(Hin[(t0 + t) * 3072 + 1792 + hh * 64 + lane]);
        ((LAS bf16*)(L + GL_KH + lane * 144))[t] = f2bf(kv * __expf(tot - bl[j])); }
    GLA_STAGE_VT()
    __syncthreads();
    f32x16 S; zero16(S);
#pragma unroll
    for (int ks = 0; ks < 4; ++ks) { const bf16x8 a = lds_rd16(L + GL_VT + (32 * vt + l31) * 144 + (16 * ks + 8 * h) * 2); const bf16x8 bb = lds_rd16(L + GL_KH + (32 * tt + l31) * 144 + (16 * ks + 8 * h) * 2); S = MFMA32(a, bb, S); }
    float* loc = LOC + (size_t)unit * 8192;
#pragma unroll
    for (int i = 0; i < 16; ++i) loc[(32 * vt + crow(i, h)) * 64 + 32 * tt + l31] = S[i];
}
DI void gla_passB(const float* LOC, const float* DEC, bf16* SST, int bh, int slice) {
    const int tid = tid_();
    const int e = slice * 1024 + tid * 2, d = e & 63;
    float s0 = 0.f, s1 = 0.f;
#pragma unroll 8
    for (int n = 0; n < 32; ++n) { const size_t unit = (size_t)bh * 32 + n;
        *(unsigned*)(SST + unit * 8192 + e) = cvtpk(s0, s1);
        const float2 l = *(const float2*)(LOC + unit * 8192 + e), dc = *(const float2*)(DEC + unit * 64 + d);
        s0 = s0 * dc.x + l.x; s1 = s1 * dc.y + l.y; }
}
DI void gla_passC_unit(const bf16* Hin, const float* G16, const float* w2, const float* b2, const float* gnorm, const bf16* SST, bf16* Omix, LAS unsigned char* L, int b, int hh, int n) {
    const int tid = tid_(), wave = __builtin_amdgcn_readfirstlane(tid >> 6), lane = tid & 63, l31 = lane & 31, h = lane >> 5;
    const int vt = wave & 3, tt = wave >> 2;
    float w2r[16];
#pragma unroll
    for (int r = 0; r < 16; ++r) w2r[r] = w2[r * 256 + hh * 64 + lane];
    const float b2r = b2[hh * 64 + lane];
    const size_t t0 = (size_t)b * SEQ + 64 * n;
    const int unit = (b * 4 + hh) * 32 + n;
    GLA_GATES(bl, tot)
    (void)tot;
#pragma unroll
    for (int j = 0; j < 8; ++j) { const int t = 8 * wave + j; const float bb = bl[j];
        const float qv = bf2f(Hin[(t0 + t) * 3072 + 1536 + hh * 64 + lane]), kv = bf2f(Hin[(t0 + t) * 3072 + 1792 + hh * 64 + lane]);
        ((LAS bf16*)(L + GL_QS + t * 144))[lane] = f2bf(qv * 0.125f * __expf(bb));
        ((LAS bf16*)(L + GL_KS + t * 144))[lane] = f2bf(kv * __expf(-bb)); }
    GLA_STAGE_VT()
#pragma unroll
    for (int i = 0; i < 2; ++i) { const int c = tid + 512 * i, v = c >> 3, ch = c & 7;
        *(LAS u32x4*)(L + GL_ST + v * 144 + ch * 16) = *(const u32x4*)(SST + (size_t)unit * 8192 + v * 64 + 8 * ch); }
    __syncthreads();
    bf16x8 qf[4];
#pragma unroll
    for (int ks = 0; ks < 4; ++ks) qf[ks] = lds_rd16(L + GL_QS + (32 * tt + l31) * 144 + (16 * ks + 8 * h) * 2);
    f32x16 at[2];
#pragma unroll
    for (int st = 0; st < 2; ++st) { zero16(at[st]);
#pragma unroll
        for (int ks = 0; ks < 4; ++ks) { const bf16x8 a = lds_rd16(L + GL_KS + (32 * st + l31) * 144 + (16 * ks + 8 * h) * 2); at[st] = MFMA32(a, qf[ks], at[st]); }
#pragma unroll
        for (int i = 0; i < 16; ++i) if (32 * st + crow(i, h) > 32 * tt + l31) at[st][i] = 0.f; }
    f32x16 oT; zero16(oT);
#pragma unroll
    for (int ks = 0; ks < 4; ++ks) { const bf16x8 a = lds_rd16(L + GL_ST + (32 * vt + l31) * 144 + (16 * ks + 8 * h) * 2); oT = MFMA32(a, qf[ks], oT); }
#pragma unroll
    for (int st = 0; st < 2; ++st)
#pragma unroll
        for (int s2 = 0; s2 < 2; ++s2) { const bf16x8 pb = pack8(at[st], s2); const bf16x8 a = lds_rd8x2(L + GL_VT + (32 * vt + l31) * 144 + (32 * st + 16 * s2 + 4 * h) * 2); oT = MFMA32(a, pb, oT); }
    float ss = 0.f;
#pragma unroll
    for (int i = 0; i < 16; ++i) ss += oT[i] * oT[i];
    ss += __shfl_xor(ss, 32);
    if (h == 0) ((LAS float*)(L + GL_SS))[wave * 32 + l31] = ss;
    __syncthreads();
    float tot2 = 0.f;
#pragma unroll
    for (int w = 0; w < 4; ++w) tot2 += ((LAS float*)(L + GL_SS))[(4 * tt + w) * 32 + l31];
    const float r = rsqrtf(tot2 * (1.f / 128.f) + 1e-6f);
    const size_t trow = t0 + 32 * tt + l31;
#pragma unroll
    for (int g4 = 0; g4 < 4; ++g4) { const int dv = 32 * vt + 8 * g4 + 4 * h; const f32x4 gn = *(const f32x4*)(gnorm + dv);
        const u32x2 rr = *(const u32x2*)(Hin + trow * 3072 + 2560 + hh * 128 + dv);
        const float r0 = siluf(bflo(rr.x)), r1 = siluf(bfhi(rr.x)), r2 = siluf(bflo(rr.y)), r3 = siluf(bfhi(rr.y));
        u32x2 w; w.x = cvtpk(oT[4 * g4] * r * gn[0] * r0, oT[4 * g4 + 1] * r * gn[1] * r1); w.y = cvtpk(oT[4 * g4 + 2] * r * gn[2] * r2, oT[4 * g4 + 3] * r * gn[3] * r3);
        *(u32x2*)(Omix + trow * 1024 + 512 + hh * 128 + dv) = w; }
}
constexpr int XA_KS = 528, XA_VT = 176, XA_OFF_V = 64 * XA_KS;
DI void xattn_unit(const bf16* Q, const bf16* KVm, bf16* Oxa, LAS unsigned char* L, int b, int hd, int qb) {
    const int tid = tid_(), wave = __builtin_amdgcn_readfirstlane(tid >> 6), lane = tid & 63, l31 = lane & 31, h = lane >> 5;
    const size_t tq = (size_t)b * SEQ + qb * 256 + wave * 32 + l31;
    f32x16 st[8];
    u32x4 pk[4];
#define XA_KLOAD(kb_) do { _Pragma("unroll") for (int i = 0; i < 4; ++i) { const int c = tid + 512 * i, key = c >> 5, ch = c & 31; \
        pk[i] = *(const u32x4*)(KVm + (size_t)(b * 256 + (kb_) * 64 + key) * 2048 + hd * 256 + 8 * ch); } } while (0)
    XA_KLOAD(0);
#pragma unroll
    for (int kb = 0; kb < 4; ++kb) {
        LBAR();
#pragma unroll
        for (int i = 0; i < 4; ++i) { const int c = tid + 512 * i, key = c >> 5, ch = c & 31; *(LAS u32x4*)(L + key * XA_KS + ch * 16) = pk[i]; }
        LBAR();
        if (kb < 3) XA_KLOAD(kb + 1);
        zero16(st[2 * kb]); zero16(st[2 * kb + 1]);
#pragma unroll
        for (int hf = 0; hf < 2; ++hf) { bf16x8 qf[8];
#pragma unroll
            for (int ks = 0; ks < 8; ++ks) qf[ks] = *(const bf16x8*)(Q + tq * 1024 + hd * 256 + 16 * (8 * hf + ks) + 8 * h);
#pragma unroll
            for (int kt = 0; kt < 2; ++kt)
#pragma unroll
                for (int ks = 0; ks < 8; ++ks) { const bf16x8 a = lds_rd16(L + (32 * kt + l31) * XA_KS + (16 * (8 * hf + ks) + 8 * h) * 2); st[2 * kb + kt] = MFMA32(a, qf[ks], st[2 * kb + kt]); }
            asm volatile("" ::: "memory"); }
    }
    u32x4 pv[2];
#define XA_VLOAD(s_) do { _Pragma("unroll") for (int i = 0; i < 2; ++i) { const int c = tid + 512 * i, key = c & 63, ch = c >> 6; \
        pv[i] = *(const u32x4*)(KVm + (size_t)(b * 256 + ((s_) & 3) * 64 + key) * 2048 + 1024 + hd * 256 + ((s_) >> 2) * 128 + 8 * ch); } } while (0)
    XA_VLOAD(0);
    const float sc = 0.0625f * LOG2E;
    float mx = -INFINITY;
#pragma unroll
    for (int j = 0; j < 8; ++j)
#pragma unroll
        for (int i = 0; i < 16; ++i) mx = fmaxf(mx, st[j][i]);
    mx = fmaxf(mx, __shfl_xor(mx, 32));
    const float nmx = -mx * sc;
    float rs = 0.f;
#pragma unroll
    for (int j = 0; j < 8; ++j)
#pragma unroll
        for (int i = 0; i < 16; ++i) { const float p = __builtin_amdgcn_exp2f(__builtin_fmaf(st[j][i], sc, nmx)); st[j][i] = p; rs += p; }
    rs += __shfl_xor(rs, 32);
    const float inv = 1.f / rs;
    bf16x8 pb[8][2];
#pragma unroll
    for (int j = 0; j < 8; ++j) {
#pragma unroll
        for (int i = 0; i < 16; ++i) st[j][i] *= inv;
        pb[j][0] = pack8(st[j], 0); pb[j][1] = pack8(st[j], 1); }
    f32x16 o[4];
#pragma unroll
    for (int s8 = 0; s8 < 8; ++s8) {
        const int dvh = s8 >> 2, kb = s8 & 3;
        if (kb == 0) {
#pragma unroll
            for (int mt = 0; mt < 4; ++mt) zero16(o[mt]); }
        LBAR();
#pragma unroll
        for (int i = 0; i < 2; ++i) { const int c = tid + 512 * i, key = c & 63, ch = c >> 6; const u32x4 vv = pv[i];
            LAS bf16* vtp = (LAS bf16*)(L + XA_OFF_V + (8 * ch) * XA_VT + kperm(key) * 2);
            vtp[0 * (XA_VT / 2)] = (bf16)(vv.x & 0xffff); vtp[1 * (XA_VT / 2)] = (bf16)(vv.x >> 16); vtp[2 * (XA_VT / 2)] = (bf16)(vv.y & 0xffff); vtp[3 * (XA_VT / 2)] = (bf16)(vv.y >> 16);
            vtp[4 * (XA_VT / 2)] = (bf16)(vv.z & 0xffff); vtp[5 * (XA_VT / 2)] = (bf16)(vv.z >> 16); vtp[6 * (XA_VT / 2)] = (bf16)(vv.w & 0xffff); vtp[7 * (XA_VT / 2)] = (bf16)(vv.w >> 16); }
        LBAR();
        if (s8 < 7) XA_VLOAD(s8 + 1);
#pragma unroll
        for (int mt = 0; mt < 4; ++mt)
#pragma unroll
            for (int kt = 0; kt < 2; ++kt)
#pragma unroll
                for (int s2 = 0; s2 < 2; ++s2) { const bf16x8 a = lds_rd16(L + XA_OFF_V + (32 * mt + l31) * XA_VT + (32 * kt + 16 * s2 + 8 * h) * 2); o[mt] = MFMA32(a, pb[2 * kb + kt][s2], o[mt]); }
        if (kb == 3) {
            bf16* orow = Oxa + tq * 1024 + hd * 256 + dvh * 128;
#pragma unroll
            for (int mt = 0; mt < 4; ++mt)
#pragma unroll
                for (int g4 = 0; g4 < 4; ++g4) { const int dv = 32 * mt + 8 * g4 + 4 * h;
                    u32x2 w; w.x = cvtpk(o[mt][4 * g4], o[mt][4 * g4 + 1]); w.y = cvtpk(o[mt][4 * g4 + 2], o[mt][4 * g4 + 3]); *(u32x2*)(orow + dv) = w; } }
    }
}
constexpr int GP_KN = 0, GP_M = 64 * 272, GP_U0 = GP_M + 64 * 68 * 4, GP_W0 = GP_U0 + 64 * 128 * 4, GP_GT = GP_W0 + 64 * 128 * 4;
DI void gdn_prep_unit(bf16* Hin, float* G16, const bf16* halo, const float* convw, const float* a_log, const float* dt_bias, bf16* Wb, LAS unsigned char* L, int b, int n, int hd, bool dry, unsigned* flag) {
    const int tid = tid_(), wave = __builtin_amdgcn_readfirstlane(tid >> 6), lane = tid & 63, l31 = lane & 31, h = lane >> 5;
    const size_t t0 = (size_t)b * SEQ + 64 * n;
    LAS float* gt = (LAS float*)(L + GP_GT);
    const int c8 = tid & 15, tr = tid >> 4;
    u32x4 raw[3][2][4];
#pragma unroll
    for (int which = 0; which < 3; ++which) { const int col = which * 1024 + hd * 128 + 8 * c8;
#pragma unroll
        for (int rr = 0; rr < 2; ++rr)
#pragma unroll
            for (int j = 0; j < 4; ++j) { const int ts = tr + 32 * rr - 3 + j; u32x4 v = {0u, 0u, 0u, 0u};
                if (ts >= 0) v = *(const u32x4*)(Hin + (t0 + ts) * 4096 + col);
                else if (n > 0) v = *(const u32x4*)(halo + ((size_t)(b * 32 + n - 1) * 3 + (ts + 3)) * 3072 + col);
                raw[which][rr][j] = v; } }
    float blv = 0.f, alv = 0.f;
    if (wave == 0) { blv = G16[(t0 + lane) * 16 + hd]; alv = G16[(t0 + lane) * 16 + 8 + hd]; }
    LBAR();
    if (wave == 0) {
        const float x = alv + dt_bias[hd];
        const float sp = fmaxf(x, 0.f) + __logf(1.f + __expf(-fabsf(x)));
        float g = -__expf(a_log[hd]) * sp;
#pragma unroll
        for (int o = 1; o < 64; o <<= 1) { const float y = __shfl_up(g, o); if (lane >= o) g += y; }
        gt[lane] = sigmoidf_(blv); gt[64 + lane] = g;
        if (!dry) __hip_atomic_store(G16 + (t0 + lane) * 16 + hd, g, __ATOMIC_RELAXED, __HIP_MEMORY_SCOPE_AGENT);
    }
    float res[2][3][8];
#pragma unroll
    for (int which = 0; which < 3; ++which) {
        const int col = which * 1024 + hd * 128 + 8 * c8;
        float wv[4][8];
#pragma unroll
        for (int j = 0; j < 4; ++j) { const f32x4 a = *(const f32x4*)(convw + (size_t)j * 3072 + col), bb = *(const f32x4*)(convw + (size_t)j * 3072 + col + 4);
#pragma unroll
            for (int e = 0; e < 4; ++e) { wv[j][e] = a[e]; wv[j][4 + e] = bb[e]; } }
#pragma unroll
        for (int rr = 0; rr < 2; ++rr) { float acc[8];
#pragma unroll
            for (int e = 0; e < 8; ++e) acc[e] = 0.f;
#pragma unroll
            for (int j = 0; j < 4; ++j) { float xf[8]; unpack8(raw[which][rr][j], xf);
#pragma unroll
                for (int e = 0; e < 8; ++e) acc[e] += wv[j][e] * xf[e]; }
#pragma unroll
            for (int e = 0; e < 8; ++e) res[rr][which][e] = siluf(acc[e]); }
    }
#pragma unroll
    for (int rr = 0; rr < 2; ++rr)
#pragma unroll
        for (int which = 0; which < 2; ++which) { float ss = 0.f;
#pragma unroll
            for (int e = 0; e < 8; ++e) ss += res[rr][which][e] * res[rr][which][e];
            ss += __shfl_xor(ss, 1); ss += __shfl_xor(ss, 2); ss += __shfl_xor(ss, 4); ss += __shfl_xor(ss, 8);
            const float r = rsqrtf(ss + 1e-6f) * (which == 0 ? 0.08838834764831845f : 1.f);
#pragma unroll
            for (int e = 0; e < 8; ++e) res[rr][which][e] *= r; }
    LBAR();
#pragma unroll
    for (int rr = 0; rr < 2; ++rr) { const int t = tr + 32 * rr; const float beta = gt[t], eg = __expf(gt[64 + t]);
        if (!dry) st16_wt(Hin + (t0 + t) * 4096 + hd * 128 + 8 * c8, packf8(res[rr][0]));
        const u32x4 kp = packf8(res[rr][1]);
        if (!dry) st16_wt(Hin + (t0 + t) * 4096 + 1024 + hd * 128 + 8 * c8, kp);
        *(LAS u32x4*)(L + GP_KN + t * 272 + c8 * 16) = kp;
        float kq[8]; unpack8(kp, kq);
        f32x4 u0a, u0b, w0a, w0b;
#pragma unroll
        for (int e = 0; e < 4; ++e) { u0a[e] = res[rr][2][e] * beta; u0b[e] = res[rr][2][4 + e] * beta; w0a[e] = kq[e] * beta * eg; w0b[e] = kq[4 + e] * beta * eg; }
        *(LAS f32x4*)(L + GP_U0 + (t * 128 + 8 * c8) * 4) = u0a; *(LAS f32x4*)(L + GP_U0 + (t * 128 + 8 * c8 + 4) * 4) = u0b;
        *(LAS f32x4*)(L + GP_W0 + (t * 128 + 8 * c8) * 4) = w0a; *(LAS f32x4*)(L + GP_W0 + (t * 128 + 8 * c8 + 4) * 4) = w0b; }
    LBAR();
    if (wave < 4) { const int mt = wave >> 1, nt = wave & 1; f32x16 c; zero16(c);
        if (!(mt == 0 && nt == 1)) {
#pragma unroll
            for (int ks = 0; ks < 8; ++ks) { const bf16x8 a = lds_rd16(L + GP_KN + (32 * mt + l31) * 272 + (16 * ks + 8 * h) * 2); const bf16x8 bb = lds_rd16(L + GP_KN + (32 * nt + l31) * 272 + (16 * ks + 8 * h) * 2); c = MFMA32(a, bb, c); } }
        const int s = 32 * nt + l31; const float gs = gt[64 + s];
#pragma unroll
        for (int g4 = 0; g4 < 4; ++g4) { f32x4 mv;
#pragma unroll
            for (int e = 0; e < 4; ++e) { const int t = 32 * mt + 8 * g4 + 4 * h + e; mv[e] = (s < t) ? gt[t] * c[4 * g4 + e] * __expf(gt[64 + t] - gs) : 0.f; }
            *(LAS f32x4*)(L + GP_M + (s * 68 + 32 * mt + 8 * g4 + 4 * h) * 4) = mv; } }
    LBAR();
    if (tid < 256) {
        LAS float* rhs = (LAS float*)(L + (tid < 128 ? GP_U0 : GP_W0)) + (tid & 127);
        float r[64];
#pragma unroll
        for (int t = 0; t < 64; ++t) r[t] = rhs[t * 128];
#pragma unroll
        for (int s0 = 0; s0 < 63; ++s0) { if ((s0 & 3) == 0) asm volatile("" ::: "memory");
            const float xs = r[s0];
#pragma unroll
            for (int q4 = (s0 + 1) / 4; q4 < 16; ++q4) { const f32x4 m = *(LAS const f32x4*)(L + GP_M + (s0 * 68 + 4 * q4) * 4);
                r[4 * q4] -= m[0] * xs; r[4 * q4 + 1] -= m[1] * xs; r[4 * q4 + 2] -= m[2] * xs; r[4 * q4 + 3] -= m[3] * xs; } }
#pragma unroll
        for (int t = 0; t < 64; ++t) rhs[t * 128] = r[t];
    }
    LBAR();
#pragma unroll 1
    for (int i = 0; i < 2; ++i) { const int c = tid + 512 * i, t = c >> 4, ch = c & 15;
        float f[8];
#pragma unroll
        for (int e = 0; e < 8; ++e) f[e] = ((LAS const float*)(L + GP_U0))[t * 128 + 8 * ch + e];
        if (!dry) st16_wt(Hin + (t0 + t) * 4096 + 2048 + hd * 128 + 8 * ch, packf8(f));
#pragma unroll
        for (int e = 0; e < 8; ++e) f[e] = ((LAS const float*)(L + GP_W0))[t * 128 + 8 * ch + e];
        if (!dry) st16_wt(Wb + (t0 + t) * 1024 + hd * 128 + 8 * ch, packf8(f)); }
    if (flag != nullptr) {
        asm volatile("s_waitcnt vmcnt(0)" ::: "memory");
        __syncthreads();
        if (tid == 0) __hip_atomic_store(flag, 1u, __ATOMIC_RELAXED, __HIP_MEMORY_SCOPE_AGENT);
    }
}
constexpr int GS_W = 0, GS_Q = 64 * 272, GS_K = 2 * 64 * 272, GS_KG = 3 * 64 * 272, GS_ST = GS_KG + 128 * 144, GS_VN = GS_ST + 128 * 272, GS_GC = GS_VN + 128 * 144, GS_SS = GS_GC + 256;
#define GS_LOAD(nn) do { const size_t t0n = (size_t)b * SEQ + 64 * (nn); \
    _Pragma("unroll") for (int i = 0; i < 2; ++i) { const int c = tid + 512 * i, t = c & 63, ch = c >> 6; \
        pw[i] = *(const u32x4*)(Wb + (t0n + t) * 1024 + hd * 128 + 8 * ch); pq[i] = *(const u32x4*)(Hin + (t0n + t) * 4096 + hd * 128 + 8 * ch); \
        pk[i] = *(const u32x4*)(Hin + (t0n + t) * 4096 + 1024 + hd * 128 + 8 * ch); pgk[i] = G16[(t0n + t) * 16 + hd]; } \
    pgc = G16[(t0n + (tid & 63)) * 16 + hd]; pgl = G16[(t0n + 63) * 16 + hd]; \
    { const size_t trn = t0n + 32 * tt + l31; \
      _Pragma("unroll") for (int g4 = 0; g4 < 4; ++g4) { pu[g4] = *(const u32x2*)(Hin + trn * 4096 + 2048 + hd * 128 + 32 * vt + 8 * g4 + 4 * h); pz[g4] = *(const u32x2*)(Hin + trn * 4096 + 3072 + hd * 128 + 32 * vt + 8 * g4 + 4 * h); } } } while (0)
DI void gdn_scan_unit(bf16* Hin, const float* G16, const bf16* Wb, const float* gnorm, LAS unsigned char* L, int b, int hd, bool dry, unsigned* flags) {
    const int tid = tid_(), wave = __builtin_amdgcn_readfirstlane(tid >> 6), lane = tid & 63, l31 = lane & 31, h = lane >> 5;
    const int vt = wave & 3, tt = wave >> 2;
    f32x16 S[2]; zero16(S[0]); zero16(S[1]);
    __syncthreads();
    for (int i = tid; i < 128 * 272 / 4; i += 512) ((LAS unsigned*)(L + GS_ST))[i] = 0u;
    LAS float* gcs = (LAS float*)(L + GS_GC);
    u32x4 pw[2], pq[2], pk[2]; float pgk[2], pgc, pgl; u32x2 pu[4], pz[4];
#define GS_WAIT(nn) do { if (flags != nullptr && tid == 0) { unsigned* f_ = flags + (b * 8 + hd) * 32 + (nn); unsigned sp_ = 0; \
        while (__hip_atomic_load(f_, __ATOMIC_RELAXED, __HIP_MEMORY_SCOPE_AGENT) == 0u) { __builtin_amdgcn_s_sleep(2); if (++sp_ > (1u << 24)) break; } \
        __builtin_amdgcn_fence(__ATOMIC_ACQUIRE, "agent"); asm volatile("s_waitcnt vmcnt(0)" ::: "memory"); } } while (0)
    GS_WAIT(0);
    __syncthreads();
    GS_LOAD(0);
    for (int n = 0; n < 32; ++n) {
        const size_t t0 = (size_t)b * SEQ + 64 * n;
        if (n < 31) GS_WAIT(n + 1);
        LBAR();
        const float gl = pgl;
        if (tid < 64) gcs[tid] = pgc;
#pragma unroll
        for (int i = 0; i < 2; ++i) { const int c = tid + 512 * i, t = c & 63, ch = c >> 6;
            *(LAS u32x4*)(L + GS_W + t * 272 + ch * 16) = pw[i];
            *(LAS u32x4*)(L + GS_Q + t * 272 + ch * 16) = pq[i];
            *(LAS u32x4*)(L + GS_K + t * 272 + ch * 16) = pk[i];
            float kf[8]; unpack8(pk[i], kf); const float e = __expf(gl - pgk[i]);
            LAS bf16* kg = (LAS bf16*)(L + GS_KG + (8 * ch) * 144 + t * 2);
#pragma unroll
            for (int j = 0; j < 8; ++j) kg[j * 72] = f2bf(kf[j] * e); }
        u32x2 cu[4], cz[4];
#pragma unroll
        for (int g4 = 0; g4 < 4; ++g4) { cu[g4] = pu[g4]; cz[g4] = pz[g4]; }
        LBAR();
        if (n < 31) GS_LOAD(n + 1);
        f32x16 vn; zero16(vn);
#pragma unroll
        for (int ks = 0; ks < 8; ++ks) { const bf16x8 a = lds_rd16(L + GS_ST + (32 * vt + l31) * 272 + (16 * ks + 8 * h) * 2); const bf16x8 bb = lds_rd16(L + GS_W + (32 * tt + l31) * 272 + (16 * ks + 8 * h) * 2); vn = MFMA32(a, bb, vn); }
#pragma unroll
        for (int g4 = 0; g4 < 4; ++g4) { const u32x2 uu = cu[g4];
            vn[4 * g4] = bflo(uu.x) - vn[4 * g4]; vn[4 * g4 + 1] = bfhi(uu.x) - vn[4 * g4 + 1]; vn[4 * g4 + 2] = bflo(uu.y) - vn[4 * g4 + 2]; vn[4 * g4 + 3] = bfhi(uu.y) - vn[4 * g4 + 3]; }
#pragma unroll
        for (int i = 0; i < 16; ++i) ((LAS bf16*)(L + GS_VN + (32 * vt + crow(i, h)) * 144))[32 * tt + l31] = f2bf(vn[i]);
        bf16x8 qf[8];
#pragma unroll
        for (int ks = 0; ks < 8; ++ks) qf[ks] = lds_rd16(L + GS_Q + (32 * tt + l31) * 272 + (16 * ks + 8 * h) * 2);
        const float gct = gcs[32 * tt + l31];
        f32x16 X[2];
#pragma unroll
        for (int st = 0; st < 2; ++st) { zero16(X[st]);
#pragma unroll
            for (int ks = 0; ks < 8; ++ks) { const bf16x8 a = lds_rd16(L + GS_K + (32 * st + l31) * 272 + (16 * ks + 8 * h) * 2); X[st] = MFMA32(a, qf[ks], X[st]); }
#pragma unroll
            for (int i = 0; i < 16; ++i) { const int s = 32 * st + crow(i, h); X[st][i] = (s <= 32 * tt + l31) ? X[st][i] * __expf(gct - gcs[s]) : 0.f; } }
        f32x16 oT; zero16(oT);
#pragma unroll
        for (int ks = 0; ks < 8; ++ks) { const bf16x8 a = lds_rd16(L + GS_ST + (32 * vt + l31) * 272 + (16 * ks + 8 * h) * 2); oT = MFMA32(a, qf[ks], oT); }
        { const float eg = __expf(gct);
#pragma unroll
          for (int i = 0; i < 16; ++i) oT[i] *= eg; }
        LBAR();
#pragma unroll
        for (int st = 0; st < 2; ++st)
#pragma unroll
            for (int s2 = 0; s2 < 2; ++s2) { const bf16x8 pb = pack8(X[st], s2); const bf16x8 a = lds_rd8x2(L + GS_VN + (32 * vt + l31) * 144 + (32 * st + 16 * s2 + 4 * h) * 2); oT = MFMA32(a, pb, oT); }
        float ss = 0.f;
#pragma unroll
        for (int i = 0; i < 16; ++i) ss += oT[i] * oT[i];
        ss += __shfl_xor(ss, 32);
        if (h == 0) ((LAS float*)(L + GS_SS))[wave * 32 + l31] = ss;
        { const float eg = __expf(gl);
#pragma unroll
          for (int j = 0; j < 2; ++j) {
#pragma unroll
              for (int i = 0; i < 16; ++i) S[j][i] *= eg;
#pragma unroll
              for (int ks = 0; ks < 4; ++ks) { const bf16x8 a = lds_rd16(L + GS_VN + (32 * vt + l31) * 144 + (16 * ks + 8 * h) * 2); const bf16x8 bb = lds_rd16(L + GS_KG + (32 * (2 * tt + j) + l31) * 144 + (16 * ks + 8 * h) * 2); S[j] = MFMA32(a, bb, S[j]); } } }
        LBAR();
        { float tot2 = 0.f;
#pragma unroll
          for (int w = 0; w < 4; ++w) tot2 += ((LAS float*)(L + GS_SS))[(4 * tt + w) * 32 + l31];
          const float r = rsqrtf(tot2 * (1.f / 128.f) + 1e-6f);
          const size_t trow = t0 + 32 * tt + l31;
#pragma unroll
          for (int g4 = 0; g4 < 4; ++g4) { const int dv = 32 * vt + 8 * g4 + 4 * h; const f32x4 gn = *(const f32x4*)(gnorm + dv);
              bf16* zp = Hin + trow * 4096 + 3072 + hd * 128 + dv;
              const u32x2 zz = cz[g4];
              const float z0 = siluf(bflo(zz.x)), z1 = siluf(bfhi(zz.x)), z2 = siluf(bflo(zz.y)), z3 = siluf(bfhi(zz.y));
              u32x2 w; w.x = cvtpk(oT[4 * g4] * r * gn[0] * z0, oT[4 * g4 + 1] * r * gn[1] * z1); w.y = cvtpk(oT[4 * g4 + 2] * r * gn[2] * z2, oT[4 * g4 + 3] * r * gn[3] * z3);
              if (!dry) *(u32x2*)zp = w; }
#pragma unroll
          for (int j = 0; j < 2; ++j)
#pragma unroll
              for (int i = 0; i < 16; ++i) ((LAS bf16*)(L + GS_ST + (32 * vt + crow(i, h)) * 272))[32 * (2 * tt + j) + l31] = f2bf(S[j][i]); }
    }
    __syncthreads();
}
#ifndef MK_MASK
#define MK_MASK 0xffff
#endif
#ifndef MK_PROBE
#define MK_PROBE 0
#endif
#define TIDS const int tid = tid_(), wave = __builtin_amdgcn_readfirstlane(tid >> 6), lane = tid & 63, gw = blk * 8 + wave, gtid = blk * 512 + tid; (void)gw; (void)gtid; (void)lane; (void)wave;

template <int layer>
DI void layer_body(const Args& args, const XcdBarrier& xbar, LAS unsigned char* L, int lo, int hi) {
    const int G = gridDim.x, blk = blockIdx.x;
    const int NGW = G * 8, gthreads = G * 512;
    unsigned char* ws = args.ws;
    float* rope = (float*)(ws + WS_ROPE); float* G16 = (float*)(ws + WS_G16); bf16* halo = (bf16*)(ws + WS_HALO);
    bf16* memb = (bf16*)(ws + WS_MEMB); bf16* KVm = (bf16*)(ws + WS_KVM); bf16* hb = (bf16*)(ws + WS_HB); bf16* big = (bf16*)(ws + WS_BIG); bf16* act = (bf16*)(ws + WS_ACT);
    float* out = args.out;
    constexpr int P = 16 * layer, cb = layer ? 29 : 10;
    float* lnstats = (float*)(ws + WS_BAR + 256 * 1024);
#define IN(k) (lo <= (k) && (k) < hi)
#define SEAM(k) do { if (IN(k) && IN((k) + 1)) xcd_barrier(xbar); } while (0)
        if (IN(P + 1)) {
            { TIDS for (int task = blk * 2 + wave; wave < 2 && task < T / 32; task += 2 * G) gate_cols(hb, (const bf16*)(ws + WS_WIN) + (size_t)(layer ? 4096 : 3072) * 1024, G16, task); }
            { const int N = layer ? 4096 : 3072;
              pg8::Gemm g{hb, (const bf16*)(ws + WS_WIN), T, N, 1024, 1024}; pg8::StaticOrder S; S.init(T, N, G, blk);
              pg8::EpiBf16 E{big, layer ? 4096 : 3072, layer ? 16 : 12, G16, layer ? halo : nullptr};
              if (MK_MASK & 128) pg8::gemm_phase<pg8::EpiBf16, pg8::StaticOrder, true, true>(L, g, S, E); }
            if (layer == 0 || G < 128) { pg8::Gemm g{memb, (const bf16*)(ws + WS_WKV), TM, 2048, 1024, 1024}; pg8::StaticOrder S; S.init(TM, 2048, G, blk);
              pg8::EpiBf16 E{KVm, 2048, 1 << 30, nullptr, nullptr};
              if (MK_MASK & 128) pg8::gemm_phase<pg8::EpiBf16, pg8::StaticOrder, true, true>(L, g, S, E); }
        }
        SEAM(P + 1);
        if (layer == 0) {
            if (IN(2)) {
                float* LOC = (float*)(ws + 184 * MiB); bf16* SST = (bf16*)(ws + 216 * MiB); float* DEC = (float*)(ws + 232 * MiB);
                for (int u = blk; u < 1024; u += G) gla_passA_unit(big, G16, inptr(6), inptr(7), LOC, DEC, L, u >> 7, (u >> 5) & 3, u & 31);
                { float lam; { TIDS const float* lf = inptr(4); const float a = wave_sum(lf[lane] * lf[64 + lane]), c = wave_sum(lf[128 + lane] * lf[192 + lane]); lam = __expf(a) - __expf(c) + 0.2f; }
                  for (int p = 0;; ++p) { const int u = (p & 1) ? (p + 1) * G - 1 - blk : p * G + blk; if (u >= 512 || p * G >= 512) break;
                      const int qb = 15 - (u >> 5), bh = u & 31; diffattn_unit(big, rope, inptr(5), hb, L, bh >> 2, bh & 3, qb, lam); } }
                xcd_barrier(xbar);
                for (int u = blk; u < 256; u += G) gla_passB(LOC, DEC, SST, u >> 3, u & 7);
                xcd_barrier(xbar);
                for (int u = blk; u < 1024; u += G) gla_passC_unit(big, G16, inptr(6), inptr(7), inptr(8), SST, hb, L, u >> 7, (u >> 5) & 3, u & 31);
            }
            SEAM(2);
        } else {
            unsigned* gflags = (unsigned*)(ws + WS_BAR) + 16384;
            const bool piped = (G >= 128);
            if (IN(P + 2)) {
                if (!piped) { for (int u = blk; u < 2048; u += G) gdn_prep_unit(big, G16, halo, inptr(24), inptr(25), inptr(26), hb, L, u >> 8, (u >> 3) & 31, u & 7, false, nullptr); }
                else if (blk >= 64) { for (int v = blk - 64; v < 2048; v += G - 64) { const int n = v >> 6, bh = v & 63; gdn_prep_unit(big, G16, halo, inptr(24), inptr(25), inptr(26), hb, L, bh >> 3, n, bh & 7, false, gflags + bh * 32 + n); } }
                else {
                    if (G != 256) { pg8::Gemm g{memb, (const bf16*)(ws + WS_WKV), TM, 2048, 1024, 1024}; pg8::StaticOrder S; S.init(TM, 2048, 64, blk);
                      pg8::EpiBf16 E{KVm, 2048, 1 << 30, nullptr, nullptr};
                      pg8::gemm_phase<pg8::EpiBf16, pg8::StaticOrder, true, true>(L, g, S, E); }
                    gdn_scan_unit(big, G16, hb, inptr(27), L, blk >> 3, blk & 7, false, gflags);
                }
            }
            SEAM(P + 2);
        }
        if (layer == 1 && G < 128) {
            if (IN(P + 3)) for (int u = blk; u < 64; u += G) gdn_scan_unit(big, G16, hb, inptr(27), L, u >> 3, u & 7, false, nullptr);
            SEAM(P + 3);
        }
        { const int ph = layer ? P + 4 : 3;
          if (IN(ph)) { pg8::Gemm g{layer ? big + 3072 : hb, (const bf16*)(ws + WS_WOUT), T, 1024, 1024, layer ? 4096 : 1024}; pg8::StaticOrder S; S.init(T, 1024, G, blk);
              pg8::EpiRes<layer == 1> E{layer ? out : inptr(0), out, lnstats, inptr(10 + 11), inptr(10 + 12), ALPHA, 0};
              pg8::gemm_phase<pg8::EpiRes<layer == 1>, pg8::StaticOrder, true, true>(L, g, S, E); }
          SEAM(ph); }
        const int Q0 = layer ? P + 5 : 4;
        if (IN(Q0)) { TIDS ln_apply(out, inptr(cb + 0), inptr(cb + 1), out, hb, lnstats, gw, NGW, lane); }
        SEAM(Q0);
        const bool qfuse = (G == 256);
        bf16* oxa = qfuse ? act : hb;
        if (IN(Q0 + 1)) { pg8::Gemm g{hb, (const bf16*)(ws + WS_WQ), T, 1024, 1024, 1024}; pg8::StaticOrder S; S.init(T, 1024, G, blk);
            pg8::EpiBf16 E{big, 1024, 1 << 30, nullptr, nullptr};
            pg8::gemm_phase<pg8::EpiBf16, pg8::StaticOrder, true, true>(L, g, S, E);
            if (qfuse) { int qpm, qpn; if (so_next(S, 0, qpm, qpn)) { asm volatile("s_waitcnt vmcnt(0)" ::: "memory"); __syncthreads(); xattn_unit(big, KVm, oxa, L, qpm >> 3, qpn, qpm & 7); } } }
        if (!qfuse) { SEAM(Q0 + 1);
            if (IN(Q0 + 2)) for (int u = blk; u < 256; u += G) xattn_unit(big, KVm, oxa, L, u >> 5, (u >> 3) & 3, u & 7); }
        SEAM(Q0 + 2);
        if (IN(Q0 + 3)) { pg8::Gemm g{oxa, (const bf16*)(ws + WS_WO), T, 1024, 1024, 1024}; pg8::StaticOrder S; S.init(T, 1024, G, blk);
            pg8::EpiRes<true> E{out, out, lnstats, inptr(cb + 0), inptr(cb + 1), ALPHA, 0};
            pg8::gemm_phase<pg8::EpiRes<true>, pg8::StaticOrder, true, true>(L, g, S, E); }
        SEAM(Q0 + 3);
        if (IN(Q0 + 4)) { TIDS ln_apply(out, inptr(cb + 5), inptr(cb + 6), out, hb, lnstats, gw, NGW, lane); }
        SEAM(Q0 + 4);
        if (IN(Q0 + 5)) { pg8::Gemm g{hb, (const bf16*)(ws + WS_WFI), T, 2 * DFF, 1024, 1024}; pg8::StaticOrder S; S.init(T, 2 * DFF, G, blk);
            pg8::EpiFfn E{big, inptr(cb + 8), inptr(cb + 9), (float*)(ws + WS_ACT), L + 131072};
            pg8::gemm_phase<pg8::EpiFfn, pg8::StaticOrder, true, true>(L, g, S, E);
            if (layer == 0 && G == 256 && blk >= 128 && blk < 192) {
                pg8::Gemm g2{memb, (const bf16*)(ws + WS_WKV1), TM, 2048, 1024, 1024}; pg8::StaticOrder S2; S2.init(TM, 2048, 64, blk - 128);
                pg8::EpiBf16 E2{KVm, 2048, 1 << 30, nullptr, nullptr};
                pg8::gemm_phase<pg8::EpiBf16, pg8::StaticOrder, true, true>(L, g2, S2, E2); } }
        SEAM(Q0 + 5);
        if (IN(Q0 + 5) && IN(Q0 + 7)) { pg8::Gemm g{big, (const bf16*)(ws + WS_WFOA), T, 1024, DFF, DFF}; pg8::StaticOrder S; S.init(T, 1024, G, blk);
            { TIDS int fpm, fpn; for (int i = 0; so_next(S, i, fpm, fpn); ++i) ffn_fix((const float*)(ws + WS_ACT), big, inptr(cb + 8), inptr(cb + 9), fpm, tid);
              asm volatile("s_waitcnt vmcnt(0)" ::: "memory"); __syncthreads(); }
            pg8::EpiRes<true> E{out, out, lnstats, inptr(cb + 5), inptr(cb + 6), ALPHA, 0};
            pg8::gemm_phase<pg8::EpiRes<true>, pg8::StaticOrder, true, true>(L, g, S, E); }
        SEAM(Q0 + 7);
        const int LN3 = Q0 + 8;
        if (IN(LN3)) { TIDS ln_apply(out, inptr(cb + 11), inptr(cb + 12), out, layer ? nullptr : hb, layer ? nullptr : lnstats, gw, NGW, lane);
            if (layer == 0) { if (MK_MASK & 1) convert_weights(args, 1, L, gw, NGW, wave, lane); } }
        if (layer == 0) SEAM(LN3);

#undef IN
#undef SEAM
}
#ifndef MK_CG_SEAM0
#define MK_CG_SEAM0 0
#endif
#ifndef MK_PER_PHASE
#define MK_PER_PHASE 0
#endif
#ifndef MK_MASK
#define MK_MASK 0xffff
#endif
#ifndef MK_PROBE
#define MK_PROBE 0
#endif
constexpr int NPHASE = 33;
__global__ void __launch_bounds__(512, 2) mk_fwd(Args args) {
    extern __shared__ __attribute__((aligned(16))) unsigned char lds_raw[];
    LAS unsigned char* L = (LAS unsigned char*)lds_raw;
    const int G = gridDim.x, blk = blockIdx.x;
    const int NGW = G * 8, gthreads = G * 512;
    unsigned char* ws = args.ws;
    float* rope = (float*)(ws + WS_ROPE); float* G16 = (float*)(ws + WS_G16); bf16* halo = (bf16*)(ws + WS_HALO);
    bf16* memb = (bf16*)(ws + WS_MEMB); bf16* KVm = (bf16*)(ws + WS_KVM); bf16* hb = (bf16*)(ws + WS_HB); bf16* big = (bf16*)(ws + WS_BIG); bf16* act = (bf16*)(ws + WS_ACT);
    const int lo = args.ph_lo, hi = args.ph_hi;
    volatile LAS unsigned* xst = (volatile LAS unsigned*)(L + LDS_BYTES - 16);
    if (threadIdx.x < 4) xst[threadIdx.x] = 0u;
    __syncthreads();
    const XcdBarrier xbar = xcd_barrier_post((unsigned*)(ws + WS_BAR), xst);
#define IN(k) (lo <= (k) && (k) < hi)
#define SEAM(k) do { if (IN(k) && IN((k) + 1)) xcd_barrier(xbar); } while (0)
    float* out = args.out;
    if (IN(0)) { TIDS
        if (MK_MASK & 1) convert_weights(args, 0, L, gw, NGW, wave, lane);
        to_bf16(inptr(0), hb, (size_t)T * D, gtid, gthreads);
        to_bf16(inptr(1), memb, (size_t)TM * D, gtid, gthreads);
        { LAS float* scr = (LAS float*)(L + wave * 16384); const float* wkv1 = inptr(29 + 3);
          for (int r = gw; r < 16 * 64; r += NGW) { const int kb = r / 64, n0 = 32 * (r % 64); transpose_item(wkv1, 2048, (bf16*)(ws + WS_WKV1), 1024, 64 * kb, n0, n0, 64 * kb, scr, lane); } }
        rope_table((const int*)inptr(2), rope, gtid, gthreads);
    }
#if MK_CG_SEAM0
    if (IN(0) && IN(1)) cg::this_grid().sync();
#else
    SEAM(0);
#endif
    layer_body<0>(args, xbar, L, lo, hi);
    layer_body<1>(args, xbar, L, lo, hi);
#undef IN
#undef SEAM
}

extern "C" void kernel_launch(void* const* d_in, const int* in_sizes, int n_in, void* d_out, int out_size, void* d_ws, size_t ws_size, hipStream_t stream) {
    static int grid = 0;
    if (grid == 0) {
        int dev = 0, cus = 0, per_cu = 0;
        hipGetDevice(&dev); hipDeviceGetAttribute(&cus, hipDeviceAttributeMultiprocessorCount, dev);
        hipFuncSetAttribute((const void*)mk_fwd, hipFuncAttributeMaxDynamicSharedMemorySize, LDS_BYTES);
        if (hipOccupancyMaxActiveBlocksPerMultiprocessor(&per_cu, (const void*)mk_fwd, 512, LDS_BYTES) != hipSuccess || per_cu < 1) { per_cu = 1; (void)hipGetLastError(); }
        grid = cus * per_cu; if (grid > 256) grid = 256;
        if (n_in != 42 || ws_size < 256 * MiB) fprintf(stderr, "kernel_launch: unexpected n_in %d / ws %zu\n", n_in, ws_size);
    }
    Args a{};
    for (int i = 0; i < 42; ++i) a.in[i] = (const float*)d_in[i];
    a.out = (float*)d_out; a.ws = (unsigned char*)d_ws;
    (void)hipMemsetAsync((unsigned char*)d_ws + WS_BAR, 0, 16384 * 4 + 2048 * 4, stream);
#if MK_PER_PHASE
    for (int p = 0; p < NPHASE; ++p) { a.ph_lo = p; a.ph_hi = p + 1; hipLaunchKernelGGL(mk_fwd, dim3(grid), dim3(512), LDS_BYTES, stream, a); }
#else
    a.ph_lo = 0; a.ph_hi = NPHASE;
    void* kargs[] = {&a};
    hipError_t e = hipLaunchCooperativeKernel((const void*)mk_fwd, dim3(grid), dim3(512), kargs, LDS_BYTES, stream);
    if (e != hipSuccess) fprintf(stderr, "cooperative launch failed: %s (grid %d)\n", hipGetErrorString(e), grid);
#endif
}
```
